# Optimizing an MI355X kernel written in HIP

```python
import math
import jax, jax.numpy as jnp
from jax import lax
import numpy as np

D_MODEL = 2048
BATCH = 2
SEQ = 16384
DEPTH = 4

N_MIXERS = 3
N_A = (DEPTH + 2) // 3
N_B = (DEPTH + 1) // 3
N_C = DEPTH // 3
D_FF = 5632
EPS = 1e-6
NA_HEAD_DIM = 32
NA_HEADS = D_MODEL // NA_HEAD_DIM
GRID_W = 64
WIN_H = 8
WIN_W = 16
CHUNK = 128
D_SGU = 2 * D_MODEL
SGU_GROUPS = 16
SGU_GROUP_DIM = D_SGU // SGU_GROUPS
POOL_WINDOWS = (2, 4, 8, 16)
POOL_GROUPS = len(POOL_WINDOWS)
POOL_GROUP_DIM = D_MODEL // POOL_GROUPS

kernel_name = "hybrid_natten_sgu_pool_macaron"


def rmsnorm(x, g):
    xf = x.astype(jnp.float32)
    y = xf * lax.rsqrt(jnp.mean(xf * xf, axis=-1, keepdims=True) + EPS)
    return (y * g.astype(jnp.float32)).astype(x.dtype)


def swiglu(h, w_gate, w_up, w_down):
    return (jax.nn.silu(h @ w_gate) * (h @ w_up)) @ w_down


def neighbourhood_attention(h, w_qkv, q_gain, k_gain, rpb, w_o):
    B, T, D = h.shape
    rows = T // GRID_W
    kh = min(WIN_H, rows)
    qkv = h @ w_qkv
    q, k, v = jnp.split(qkv, 3, axis=-1)
    shp = (B, rows, GRID_W, NA_HEADS, NA_HEAD_DIM)
    q = rmsnorm(q.reshape(shp), q_gain) * (NA_HEAD_DIM ** -0.5)
    k = rmsnorm(k.reshape(shp), k_gain)
    v = v.reshape(shp)
    cols = np.arange(GRID_W)
    col_start = np.clip(cols - WIN_W // 2, 0, GRID_W - WIN_W)
    col_idx = col_start[:, None] + np.arange(WIN_W)[None, :]
    dc_idx = col_idx - cols[:, None] + (WIN_W - 1)

    def row_block(r):
        rs = jnp.clip(r - kh // 2, 0, rows - kh)
        k_rows = lax.dynamic_slice_in_dim(k, rs, kh, axis=1)
        v_rows = lax.dynamic_slice_in_dim(v, rs, kh, axis=1)
        k_win = k_rows[:, :, col_idx]
        v_win = v_rows[:, :, col_idx]
        q_r = lax.dynamic_index_in_dim(q, r, axis=1, keepdims=False)
        s = jnp.einsum('bchd,bicjhd->bhcij', q_r, k_win).astype(jnp.float32)
        dr_idx = rs + jnp.arange(kh) - r + (WIN_H - 1)
        bias = rpb[:, dr_idx[:, None, None], dc_idx[None, :, :]]
        s = s + jnp.transpose(bias, (0, 2, 1, 3))[None].astype(jnp.float32)
        p = jax.nn.softmax(s.reshape(B, NA_HEADS, GRID_W, kh * WIN_W), axis=-1)
        p = p.reshape(B, NA_HEADS, GRID_W, kh, WIN_W).astype(v.dtype)
        return jnp.einsum('bhcij,bicjhd->bchd', p, v_win)

    out = lax.map(row_block, jnp.arange(rows))
    out = jnp.transpose(out, (1, 0, 2, 3, 4)).reshape(B, T, D)
    return out @ w_o


def spatial_gating(h, w_in, v_gain, w_s, b_s, w_out):
    B, T, D = h.shape
    z = jax.nn.gelu(h @ w_in, approximate=False)
    u, v = jnp.split(z, 2, axis=-1)
    v = rmsnorm(v, v_gain)
    v = v.reshape(B, T // CHUNK, CHUNK, SGU_GROUPS, SGU_GROUP_DIM)
    v = jnp.einsum('gij,bnjgd->bnigd', w_s, v) + jnp.transpose(b_s)[None, None, :, :, None]
    return (u * v.reshape(B, T, D_SGU)) @ w_out


def multiscale_pool(h, w_grp, scale):
    B, T, D = h.shape
    hf = h.astype(jnp.float32)
    cs = jnp.concatenate([jnp.zeros((B, 1, D), jnp.float32), jnp.cumsum(hf, axis=1)], axis=1)
    t = jnp.arange(T)
    parts = []
    for g, w in enumerate(POOL_WINDOWS):
        lo = jnp.clip(t - w // 2, 0, T)
        hi = jnp.clip(t + w // 2, 0, T)
        sl = slice(g * POOL_GROUP_DIM, (g + 1) * POOL_GROUP_DIM)
        cg = cs[..., sl]
        cnt = (hi - lo).astype(jnp.float32)[None, :, None]
        parts.append((cg[:, hi] - cg[:, lo]) / cnt - hf[..., sl])
    p = jnp.concatenate(parts, axis=-1).astype(h.dtype).reshape(B, T, POOL_GROUPS, POOL_GROUP_DIM)
    y = jnp.einsum('btgc,gcd->btgd', p, w_grp).reshape(B, T, D)
    return y * scale


def _w(key, shape, fan_in):
    return jax.random.normal(key, shape, jnp.float32) * (fan_in ** -0.5)


def _gain(key, shape):
    return 1.0 + 0.02 * jax.random.normal(key, shape, jnp.float32)


def setup_inputs(seed: int = 0) -> dict:
    key = jax.random.key(seed)
    ks = jax.random.split(key, 24)
    D = D_MODEL
    return {
        "x": jax.random.normal(ks[0], (BATCH, SEQ, D), jnp.float32),
        "ffn1_norm": _gain(ks[1], (DEPTH, D)),
        "ffn1_w_gate": _w(ks[2], (DEPTH, D, D_FF), D),
        "ffn1_w_up": _w(ks[3], (DEPTH, D, D_FF), D),
        "ffn1_w_down": _w(ks[4], (DEPTH, D_FF, D), D_FF),
        "mix_norm": _gain(ks[5], (DEPTH, D)),
        "ffn2_norm": _gain(ks[6], (DEPTH, D)),
        "ffn2_w_gate": _w(ks[7], (DEPTH, D, D_FF), D),
        "ffn2_w_up": _w(ks[8], (DEPTH, D, D_FF), D),
        "ffn2_w_down": _w(ks[9], (DEPTH, D_FF, D), D_FF),
        "out_norm": _gain(ks[10], (DEPTH, D)),
        "na_w_qkv": _w(ks[11], (N_A, D, 3 * D), D),
        "na_q_gain": _gain(ks[12], (N_A, NA_HEAD_DIM)),
        "na_k_gain": _gain(ks[13], (N_A, NA_HEAD_DIM)),
        "na_rpb": 0.1 * jax.random.normal(ks[14], (N_A, NA_HEADS, 2 * WIN_H - 1, 2 * WIN_W - 1), jnp.float32),
        "na_w_o": _w(ks[15], (N_A, D, D), D),
        "sgu_w_in": _w(ks[16], (N_B, D, 2 * D_SGU), D),
        "sgu_v_gain": _gain(ks[17], (N_B, D_SGU)),
        "sgu_w_s": _w(ks[18], (N_B, SGU_GROUPS, CHUNK, CHUNK), CHUNK),
        "sgu_b_s": _gain(ks[19], (N_B, SGU_GROUPS, CHUNK)),
        "sgu_w_out": _w(ks[20], (N_B, D_SGU, D), D_SGU),
        "pool_w": _w(ks[21], (N_C, POOL_GROUPS, POOL_GROUP_DIM, POOL_GROUP_DIM), POOL_GROUP_DIM),
        "pool_scale": _gain(ks[22], (N_C, D)),
    }


def reference(x, ffn1_norm, ffn1_w_gate, ffn1_w_up, ffn1_w_down, mix_norm,
              ffn2_norm, ffn2_w_gate, ffn2_w_up, ffn2_w_down, out_norm,
              na_w_qkv, na_q_gain, na_k_gain, na_rpb, na_w_o,
              sgu_w_in, sgu_v_gain, sgu_w_s, sgu_b_s, sgu_w_out,
              pool_w, pool_scale):
    for i in range(DEPTH):
        x = x + 0.5 * swiglu(rmsnorm(x, ffn1_norm[i]), ffn1_w_gate[i], ffn1_w_up[i], ffn1_w_down[i])
        h = rmsnorm(x, mix_norm[i])
        kind, j = i % N_MIXERS, i // N_MIXERS
        if kind == 0:
            y = neighbourhood_attention(h, na_w_qkv[j], na_q_gain[j], na_k_gain[j], na_rpb[j], na_w_o[j])
        elif kind == 1:
            y = spatial_gating(h, sgu_w_in[j], sgu_v_gain[j], sgu_w_s[j], sgu_b_s[j], sgu_w_out[j])
        else:
            y = multiscale_pool(h, pool_w[j], pool_scale[j])
        x = x + y
        x = x + 0.5 * swiglu(rmsnorm(x, ffn2_norm[i]), ffn2_w_gate[i], ffn2_w_up[i], ffn2_w_down[i])
        x = rmsnorm(x, out_norm[i])
    return x
```

```cpp
#include <hip/hip_runtime.h>
#include <cstdio>
#include <cstdint>

constexpr int D = 2048, SEQ = 16384, M = 32768, DEPTH = 4, DFF = 5632;
constexpr int NHEAD = 64, HD = 32, GRID_W = 64, GROWS = 256, NQKV = 3 * D;
constexpr int DSGU = 4096, SGU_IN = 8192, CHUNK = 128, SGG = 16, SGD = 256;
constexpr int PGD = 512;
constexpr float EPS = 1e-6f;
constexpr float LOG2E = 1.4426950408889634f;
constexpr float QSCALE = 0.17677669529663687f * LOG2E;

typedef unsigned short bf16_t;
#define LAS __attribute__((address_space(3)))
#define GAS __attribute__((address_space(1)))
typedef short bf16x8 __attribute__((ext_vector_type(8)));
typedef float f32x4 __attribute__((ext_vector_type(4)));
typedef float f32x2 __attribute__((ext_vector_type(2)));
typedef unsigned u32x4 __attribute__((ext_vector_type(4)));
typedef unsigned u32x2 __attribute__((ext_vector_type(2)));

__device__ __forceinline__ unsigned cvt_pk_bf16(float lo, float hi) { unsigned r; asm volatile("v_cvt_pk_bf16_f32 %0, %1, %2" : "=v"(r) : "v"(lo), "v"(hi)); return r; }
__device__ __forceinline__ float bflo(unsigned w) { return __uint_as_float(w << 16); }
__device__ __forceinline__ float bfhi(unsigned w) { return __uint_as_float(w & 0xffff0000u); }
__device__ __forceinline__ float bf2f(bf16_t b) { return __uint_as_float(((unsigned)b) << 16); }
__device__ __forceinline__ float rsq(float x) { return __builtin_amdgcn_rsqf(x); }
typedef unsigned long long u64;
constexpr float STAT_SCALE = 4194304.0f, STAT_INV = 1.0f / 4194304.0f;
__device__ __forceinline__ u64 stat_fix(float s) { return (u64)(long long)__float2ll_rn(s * STAT_SCALE); }
__device__ __forceinline__ float stat_f(u64 v) { return ((float)(unsigned)(v >> 32) * 4294967296.0f + (float)(unsigned)v) * STAT_INV; }
__device__ __forceinline__ float stat_get(const u64* p, int r) { return stat_f(p[r]); }
__device__ __forceinline__ void stat_add(u64* p, int r, float s) { atomicAdd(p + r, stat_fix(s)); }

#ifndef PG8_PRIO
#define PG8_PRIO 1
#endif
#ifndef PG8_SP2
#define PG8_SP2 1
#endif
namespace pg8 {
constexpr int BM = 256, BK = 64, HALF = 128, HTB = HALF * BK * 2, STAGE_BYTES = 8 * HTB, NXCD = 8, WGM = 8;
__host__ __device__ __forceinline__ int lds_byte(int r, int c) { const int st = (r >> 4) * 2 + (c >> 5), rr = r & 15, cc = c & 31, ob = rr * 64 + cc * 2; return st * 1024 + (ob ^ (((ob >> 9) & 1) << 5)); }
__host__ __device__ __forceinline__ void stage_rc(int b, int& R, int& C) { const int st = b / 1024, sb = b % 1024, swz = sb ^ (((sb >> 9) & 1) << 5); R = (st >> 1) * 16 + swz / 64; C = (st & 1) * 32 + (swz % 64) / 2; }
__host__ __device__ __forceinline__ int perm32(int rho) { const int n = rho >> 4, i = rho & 15; return 8 * (i >> 2) + 4 * n + (i & 3); }

struct Unit { int pm, pn; };
template <int N_, int K_, int LDA_, int LDB_, int GT_ = 0, int GAB_ = 0, int WGM_ = 8, int ATILE_ = 0> struct Shape { static constexpr int N = N_, K = K_, LDA = LDA_, LDB = LDB_, GT = GT_, GAB = GAB_, WGMS = WGM_, ATILE = ATILE_; };

template <int nM, int nN, int WGMS> struct StaticOrder {
    int G, c;
    __device__ __forceinline__ bool next(int i, Unit& u) const {
        constexpr int nwg = nM * nN;
        const int L = i * G + c; if (L >= nwg) return false;
        int wgid = L; { constexpr int q = nwg / NXCD, r = nwg % NXCD; const int xcd = wgid % NXCD, off = wgid / NXCD; wgid = (xcd < r ? xcd * (q + 1) : r * (q + 1) + (xcd - r) * q) + off; }
        constexpr int nig = WGMS * nN; const int gid = wgid / nig, fm = gid * WGMS, gsz = (nM - fm) < WGMS ? (nM - fm) : WGMS;
        u.pm = fm + ((wgid % nig) % gsz); u.pn = (wgid % nig) / gsz; return true;
    }
};

template <class Epi, class SH>
__device__ __forceinline__ void gemm_phase(LAS unsigned char* lds, const bf16_t* gA, const bf16_t* gBt, int G_, int c_, Epi& E) {
    StaticOrder<32768 / BM, SH::N / BM, SH::WGMS> S; S.G = G_; S.c = c_;
    int tid_ = threadIdx.x; asm volatile("" : "+v"(tid_));
    const int tid = tid_, wid = __builtin_amdgcn_readfirstlane(tid >> 6), lane = tid & 63, wr = wid >> 2, wc = wid & 3, fr = lane & 15, fq = lane >> 4;
    constexpr int nt = SH::K / BK;
    unsigned voffA[2], voffB[2];
#pragma unroll
    for (int i = 0; i < 2; ++i) { int R, C; stage_rc(tid * 16 + i * 8192, R, C); const int Rb = Epi::PERM ? ((R & ~31) + perm32(R & 31)) : R;
        voffA[i] = SH::ATILE ? (unsigned)(((R >> 4) * (SH::LDA / 32) + (C >> 5)) * 1024 + (R & 15) * 64 + (C & 31) * 2) : (unsigned)(R * SH::LDA + C) * 2u;
        static_assert(Epi::PERM, "the weight copies are stored pre-permuted"); (void)Rb;
        voffB[i] = (unsigned)(((R >> 4) * (SH::LDB / 32) + (C >> 5)) * 1024 + (R & 15) * 64 + (C & 31) * 2); }
    const unsigned kstep = 2048u, kstepA = SH::ATILE ? 2048u : (unsigned)(BK * 2);
    constexpr unsigned hA = (unsigned)HALF * SH::LDA * 2, hB = (unsigned)HALF * SH::LDB * 2, tA = 2 * hA, tB = 2 * hB;
    const __amdgpu_buffer_rsrc_t rsA = __builtin_amdgcn_make_buffer_rsrc((void*)gA, 0, -1, 0x00020000), rsB = __builtin_amdgcn_make_buffer_rsrc((void*)gBt, 0, -1, 0x00020000);
    const unsigned ldsw = (unsigned)wid * 1024u;
    const int aoff = lds_byte(wr * 64 + fr, fq * 8), boff = lds_byte(wc * 32 + fr, fq * 8);
#define PG8_APTR(u) ((unsigned)(u).pm * tA + (SH::GT ? (unsigned)((u).pn / (SH::GT ? SH::GT : 1)) * (unsigned)SH::GAB : 0u))
#define PG8_BPTR(u) ((unsigned)(u).pn * tB)
#define PG8_RS_voffA rsA
#define PG8_RS_voffB rsB
#define PG8_SA(b, h) (((b) * 2 + (h)) * HTB)
#define PG8_SB(b, h) ((4 + (b) * 2 + (h)) * HTB)
#define PG8_STAGE(bufoff, gbase, voff) do { _Pragma("unroll") for (int _i = 0; _i < 2; ++_i) \
        __builtin_amdgcn_raw_ptr_buffer_load_lds(PG8_RS_##voff, (LAS unsigned*)(lds + (bufoff) + ldsw + _i * 8192), 16, (int)(voff)[_i], (int)(gbase), 0, 0); } while (0)
#define PG8_LDA(dst, b, h) do { _Pragma("unroll") for (int m = 0; m < 4; ++m) _Pragma("unroll") for (int k = 0; k < 2; ++k) dst[m][k] = *(const LAS bf16x8*)(lds + PG8_SA(b, h) + aoff + m * 2048 + k * 1024); } while (0)
#define PG8_LDB(dst, b, h) do { _Pragma("unroll") for (int n = 0; n < 2; ++n) _Pragma("unroll") for (int k = 0; k < 2; ++k) dst[n][k] = *(const LAS bf16x8*)(lds + PG8_SB(b, h) + boff + n * 2048 + k * 1024); } while (0)
#define PG8_MMA(ai, bj, At, Bt) do { if (PG8_PRIO) __builtin_amdgcn_s_setprio(1); _Pragma("unroll") for (int m = 0; m < 4; ++m) _Pragma("unroll") for (int n = 0; n < 2; ++n) _Pragma("unroll") for (int k = 0; k < 2; ++k) \
        acc[ai][bj][m][n] = __builtin_amdgcn_mfma_f32_16x16x32_bf16(Bt[n][k], At[m][k], acc[ai][bj][m][n], 0, 0, 0); if (PG8_PRIO) __builtin_amdgcn_s_setprio(0); } while (0)
#define PG8_WAIT_V(n) asm volatile("s_waitcnt vmcnt(" #n ")" ::: "memory")
#define PG8_WAIT_L(n) asm volatile("s_waitcnt lgkmcnt(" #n ")" ::: "memory")
#define PG8_BAR __builtin_amdgcn_s_barrier()
#define PG8_SCHED __builtin_amdgcn_sched_barrier(0)
    Unit cur, nxt; int ui = 0;
    if (!S.next(0, cur)) return;
    f32x4 acc[2][2][4][2];
#pragma unroll
    for (int a = 0; a < 2; ++a)
#pragma unroll
        for (int b = 0; b < 2; ++b)
#pragma unroll
            for (int m = 0; m < 4; ++m)
#pragma unroll
                for (int n = 0; n < 2; ++n) acc[a][b][m][n] = (f32x4){0.f, 0.f, 0.f, 0.f};
    bf16x8 At[4][2], B0[2][2], B1[2][2];
    unsigned cA = PG8_APTR(cur), cB = PG8_BPTR(cur);
#if PG8_SP2
    PG8_STAGE(PG8_SB(0, 0), cB, voffB); PG8_STAGE(PG8_SB(0, 1), cB + hB, voffB); PG8_STAGE(PG8_SA(0, 0), cA, voffA); PG8_STAGE(PG8_SA(0, 1), cA + hA, voffA);
    if (wr == 1) PG8_BAR;
    PG8_WAIT_V(2); PG8_BAR;
    PG8_STAGE(PG8_SB(1, 0), cB + kstep, voffB); PG8_STAGE(PG8_SA(1, 0), cA + kstepA, voffA); PG8_STAGE(PG8_SB(1, 1), cB + hB + kstep, voffB);
    PG8_WAIT_V(6); PG8_BAR;
#else
    PG8_STAGE(PG8_SB(0, 0), cB, voffB); PG8_STAGE(PG8_SA(0, 0), cA, voffA); PG8_STAGE(PG8_SB(0, 1), cB + hB, voffB); PG8_STAGE(PG8_SA(0, 1), cA + hA, voffA);
    if (wr == 1) PG8_BAR;
    PG8_WAIT_V(4); PG8_BAR;
    PG8_STAGE(PG8_SB(1, 0), cB + kstep, voffB); PG8_STAGE(PG8_SA(1, 0), cA + kstepA, voffA); PG8_STAGE(PG8_SB(1, 1), cB + hB + kstep, voffB);
    PG8_WAIT_V(6); PG8_BAR;
#endif
    for (;;) {
        const bool has_next = S.next(ui + 1, nxt);
        const unsigned nA = has_next ? PG8_APTR(nxt) : cA, nB = has_next ? PG8_BPTR(nxt) : cB;
        for (int t = 0; t < nt; t += 2) {
            const bool last = (t == nt - 2);
            const unsigned a1 = cA + (unsigned)(t + 1) * kstepA;
            const unsigned a2 = last ? nA : cA + (unsigned)(t + 2) * kstepA, b2 = last ? nB : cB + (unsigned)(t + 2) * kstep;
            const unsigned a3 = a2 + kstepA, b3 = b2 + kstep;
#if PG8_SP2
            PG8_LDB(B0, 0, 0); PG8_LDB(B1, 0, 1); PG8_SCHED; PG8_LDA(At, 0, 0); PG8_STAGE(PG8_SA(1, 1), a1 + hA, voffA);
            PG8_WAIT_V(8); PG8_WAIT_L(0); PG8_BAR; PG8_MMA(0, 0, At, B0); PG8_MMA(0, 1, At, B1); PG8_BAR; PG8_SCHED;
            PG8_LDA(At, 0, 1); PG8_STAGE(PG8_SB(0, 0), b2, voffB); PG8_STAGE(PG8_SB(0, 1), b2 + hB, voffB); PG8_STAGE(PG8_SA(0, 0), a2, voffA);
            PG8_WAIT_V(8); PG8_WAIT_L(0); PG8_BAR; PG8_MMA(1, 0, At, B0); PG8_MMA(1, 1, At, B1); PG8_BAR; PG8_SCHED;
            PG8_LDB(B0, 1, 0); PG8_LDB(B1, 1, 1); PG8_SCHED; PG8_LDA(At, 1, 0); PG8_STAGE(PG8_SA(0, 1), a2 + hA, voffA);
            PG8_WAIT_V(8); PG8_WAIT_L(0); PG8_BAR; PG8_MMA(0, 0, At, B0); PG8_MMA(0, 1, At, B1); PG8_BAR; PG8_SCHED;
            PG8_LDA(At, 1, 1); PG8_STAGE(PG8_SB(1, 0), b3, voffB); PG8_STAGE(PG8_SB(1, 1), b3 + hB, voffB); PG8_STAGE(PG8_SA(1, 0), a3, voffA);
            PG8_WAIT_V(8); PG8_WAIT_L(0); PG8_BAR; PG8_MMA(1, 0, At, B0); PG8_MMA(1, 1, At, B1); PG8_BAR; PG8_SCHED;
#else
            PG8_LDB(B0, 0, 0); PG8_SCHED; PG8_LDA(At, 0, 0); PG8_STAGE(PG8_SA(1, 1), a1 + hA, voffA);
            PG8_WAIT_L(8); PG8_BAR; PG8_WAIT_L(0); PG8_MMA(0, 0, At, B0); PG8_BAR; PG8_SCHED;
            PG8_LDB(B1, 0, 1); PG8_STAGE(PG8_SB(0, 0), b2, voffB);
            PG8_BAR; PG8_WAIT_L(0); PG8_MMA(0, 1, At, B1); PG8_BAR;
            PG8_LDA(At, 0, 1); PG8_STAGE(PG8_SA(0, 0), a2, voffA);
            PG8_BAR; PG8_WAIT_L(0); PG8_MMA(1, 0, At, B0); PG8_BAR; PG8_SCHED;
            PG8_STAGE(PG8_SB(0, 1), b2 + hB, voffB);
            PG8_WAIT_V(6); PG8_BAR; PG8_MMA(1, 1, At, B1); PG8_BAR;
            PG8_LDB(B0, 1, 0); PG8_SCHED; PG8_LDA(At, 1, 0); PG8_STAGE(PG8_SA(0, 1), a2 + hA, voffA);
            PG8_WAIT_L(8); PG8_BAR; PG8_WAIT_L(0); PG8_MMA(0, 0, At, B0); PG8_BAR; PG8_SCHED;
            PG8_LDB(B1, 1, 1); PG8_STAGE(PG8_SB(1, 0), b3, voffB);
            PG8_BAR; PG8_WAIT_L(0); PG8_MMA(0, 1, At, B1); PG8_BAR;
            PG8_LDA(At, 1, 1); PG8_STAGE(PG8_SA(1, 0), a3, voffA);
            PG8_BAR; PG8_WAIT_L(0); PG8_MMA(1, 0, At, B0); PG8_BAR; PG8_SCHED;
            PG8_STAGE(PG8_SB(1, 1), b3 + hB, voffB);
            PG8_WAIT_V(6); PG8_BAR; PG8_MMA(1, 1, At, B1); PG8_BAR;
#endif
        }
        if (wr == 0) PG8_BAR;
        E(acc, cur, wr, wc, fr, fq);
        if (!has_next) break;
        if (!Epi::ZEROES)
#pragma unroll
        for (int a = 0; a < 2; ++a)
#pragma unroll
            for (int b = 0; b < 2; ++b)
#pragma unroll
                for (int m = 0; m < 4; ++m)
#pragma unroll
                    for (int n = 0; n < 2; ++n) { double z0, z1; asm volatile("v_mov_b64 %0, 0" : "=v"(z0)); asm volatile("v_mov_b64 %0, 0" : "=v"(z1));
                        const f32x2 l = __builtin_bit_cast(f32x2, z0), h = __builtin_bit_cast(f32x2, z1); acc[a][b][m][n] = (f32x4){l.x, l.y, h.x, h.y}; }
        cur = nxt; cA = nA; cB = nB; ++ui;
        if (wr == 1) PG8_BAR;
    }
    PG8_WAIT_V(0);
    PG8_BAR;
#undef PG8_APTR
#undef PG8_BPTR
#undef PG8_RS_voffA
#undef PG8_RS_voffB
#undef PG8_SA
#undef PG8_SB
#undef PG8_STAGE
#undef PG8_LDA
#undef PG8_LDB
#undef PG8_MMA
#undef PG8_WAIT_V
#undef PG8_WAIT_L
#undef PG8_BAR
#undef PG8_SCHED
}
}

__device__ __forceinline__ f32x2 gelu_pk(f32x2 v) {
    const f32x2 av = __builtin_elementwise_abs(v), d = av * 0.2316418882f + 1.0f;
    f32x2 t; t.x = __builtin_amdgcn_rcpf(d.x); t.y = __builtin_amdgcn_rcpf(d.y);
    f32x2 q = t * 0.5307027145f + (-0.7265760135f); q = q * t + 0.7107068705f; q = q * t + (-0.142248368f); q = q * t + 0.127414796f; q = q * t;
    const f32x2 s = (v * v) * (-0.72134752044f);
    f32x2 e; e.x = __builtin_amdgcn_exp2f(s.x); e.y = __builtin_amdgcn_exp2f(s.y);
    const f32x2 m = v * (q * e), r = v - m;
    f32x2 o; o.x = v.x < 0.f ? m.x : r.x; o.y = v.y < 0.f ? m.y : r.y; return o;
}
__device__ __forceinline__ float silu_f(float x) { return x * __builtin_amdgcn_rcpf(1.0f + __builtin_amdgcn_exp2f(-LOG2E * x)); }

__device__ __forceinline__ float row_ps(const u64* s1, bool has1, int r) { const float p = rsq(stat_f(s1[r]) * (1.0f / D) + EPS); return has1 ? p : 1.0f; }
__device__ __forceinline__ float row_cf(const u64* ss, const u64* s1, bool has1, int r) { const float ps = row_ps(s1, has1, r); return ps * rsq(ps * ps * stat_f(ss[r]) * (1.0f / D) + EPS); }

struct EpiSwiGLU {
    static constexpr bool PERM = true, ZEROES = true;
    bf16_t* O; const u64* ss; const u64* s1; bool has1; int cf_pm; float cfv[2][4];
    __device__ __forceinline__ void operator()(f32x4 (&acc)[2][2][4][2], const pg8::Unit& u, int wr, int wc, int fr, int fq) {
        const int row0 = u.pm * 256 + wr * 64 + fr;
        if (u.pm != cf_pm) { cf_pm = u.pm;
#pragma unroll
        for (int ai = 0; ai < 2; ++ai)
#pragma unroll
            for (int m = 0; m < 4; ++m) cfv[ai][m] = row_cf(ss, s1, has1, row0 + ai * 128 + m * 16); }
        char* const obase = (char*)O + ((size_t)(u.pm * 16 + wr * 4) * (DFF / 32) + u.pn * 4 + wc) * 1024 + fr * 64 + fq * 16;
#pragma unroll
        for (int ai = 0; ai < 2; ++ai)
#pragma unroll
            for (int m = 0; m < 4; ++m) { const float cf = cfv[ai][m], c1 = -LOG2E * cf, ic2 = __builtin_amdgcn_rcpf(cf * cf);
                u32x4 w;
#pragma unroll
                for (int n = 0; n < 2; ++n) { const f32x4 g = acc[ai][0][m][n], uu = acc[ai][1][m][n];
                    const f32x2 ga = {g[0], g[1]}, gb = {g[2], g[3]}, ua = {uu[0], uu[1]}, ub = {uu[2], uu[3]};
                    const f32x2 ta = ga * c1, tb = gb * c1; f32x2 ea, eb; ea.x = __builtin_amdgcn_exp2f(fminf(ta.x, 40.f)); ea.y = __builtin_amdgcn_exp2f(fminf(ta.y, 40.f)); eb.x = __builtin_amdgcn_exp2f(fminf(tb.x, 40.f)); eb.y = __builtin_amdgcn_exp2f(fminf(tb.y, 40.f));
                    const f32x2 da = ea * ic2 + ic2, db = eb * ic2 + ic2, pp = da * db; f32x2 rr; rr.x = __builtin_amdgcn_rcpf(pp.x); rr.y = __builtin_amdgcn_rcpf(pp.y);
                    const f32x2 oa = (ga * ua) * (rr * db), ob = (gb * ub) * (rr * da);
                    if (n == 0) { w.x = cvt_pk_bf16(oa.x, oa.y); w.y = cvt_pk_bf16(ob.x, ob.y); } else { w.z = cvt_pk_bf16(oa.x, oa.y); w.w = cvt_pk_bf16(ob.x, ob.y); } }
                *(u32x4*)(obase + (size_t)(ai * 8 + m) * (DFF / 32) * 1024) = w;
#pragma unroll
                for (int bj = 0; bj < 2; ++bj)
#pragma unroll
                    for (int n = 0; n < 2; ++n) { double z0, z1; asm volatile("v_mov_b64 %0, 0" : "=v"(z0)); asm volatile("v_mov_b64 %0, 0" : "=v"(z1));
                        const f32x2 l = __builtin_bit_cast(f32x2, z0), h = __builtin_bit_cast(f32x2, z1); acc[ai][bj][m][n] = (f32x4){l.x, l.y, h.x, h.y}; } }
    }
};
__device__ __forceinline__ size_t xb_off(int r, int c) { return ((size_t)(r >> 4) * (D / 32) + (c >> 5)) * 512 + (r & 15) * 32 + (c & 31); }
struct EpiResid {
    static constexpr bool PERM = true, ZEROES = false;
    bf16_t* XB; const u64* s1_in; bool has1; u64* ss_out; const float* gout; u64* s1_out;
    __device__ __forceinline__ void operator()(const f32x4 (&acc)[2][2][4][2], const pg8::Unit& u, int wr, int wc, int fr, int fq) {
        const int row0 = u.pm * 256 + wr * 64 + fr, col0 = u.pn * 256 + wc * 32 + 8 * fq;
        float psv[2][4];
#pragma unroll
        for (int ai = 0; ai < 2; ++ai)
#pragma unroll
            for (int m = 0; m < 4; ++m) psv[ai][m] = row_ps(s1_in, has1, row0 + ai * 128 + m * 16);
#define RESID_ROW(ai, m, XROW) do { const int r = row0 + ai * 128 + m * 16; const float ps = psv[ai][m]; float sA = 0.f, sB = 0.f; \
_Pragma("unroll") \
                for (int bj = 0; bj < 2; ++bj) { const u32x4 xw = XROW[bj]; \
                    f32x4 v0 = (f32x4){bflo(xw.x), bfhi(xw.x), bflo(xw.y), bfhi(xw.y)} * ps + acc[ai][bj][m][0], v1 = (f32x4){bflo(xw.z), bfhi(xw.z), bflo(xw.w), bfhi(xw.w)} * ps + acc[ai][bj][m][1]; \
                    if (gout) { sB += (v0[0] * v0[0] + v0[1] * v0[1]) + (v0[2] * v0[2] + v0[3] * v0[3]) + (v1[0] * v1[0] + v1[1] * v1[1]) + (v1[2] * v1[2] + v1[3] * v1[3]); \
                        v0 = v0 * *(const f32x4*)(gout + col0 + bj * 128); v1 = v1 * *(const f32x4*)(gout + col0 + bj * 128 + 4); } \
                    sA += (v0[0] * v0[0] + v0[1] * v0[1]) + (v0[2] * v0[2] + v0[3] * v0[3]) + (v1[0] * v1[0] + v1[1] * v1[1]) + (v1[2] * v1[2] + v1[3] * v1[3]); \
                    u32x4 w; w.x = cvt_pk_bf16(v0[0], v0[1]); w.y = cvt_pk_bf16(v0[2], v0[3]); w.z = cvt_pk_bf16(v1[0], v1[1]); w.w = cvt_pk_bf16(v1[2], v1[3]); \
                    *(u32x4*)(XB + xb_off(r, col0 + bj * 128)) = w; } \
                sA += __shfl_xor(sA, 16); sA += __shfl_xor(sA, 32); \
                if (gout) { sB += __shfl_xor(sB, 16); sB += __shfl_xor(sB, 32); } \
                if (fq == 0) { stat_add(ss_out, r, sA); if (gout) stat_add(s1_out, r, sB); } } while (0)
        u32x4 x0[4][2], x1[4][2];
#pragma unroll
        for (int m = 0; m < 4; ++m)
#pragma unroll
            for (int bj = 0; bj < 2; ++bj) x0[m][bj] = *(const u32x4*)(XB + xb_off(row0 + m * 16, col0 + bj * 128));
#pragma unroll
        for (int m = 0; m < 4; ++m) { RESID_ROW(0, m, x0[m]);
            if (m & 1) {
#pragma unroll
                for (int mm = m - 1; mm <= m; ++mm)
#pragma unroll
                    for (int bj = 0; bj < 2; ++bj) x1[mm][bj] = *(const u32x4*)(XB + xb_off(row0 + 128 + mm * 16, col0 + bj * 128)); } }
        asm volatile("" ::: "memory");
#pragma unroll
        for (int m = 0; m < 4; ++m) RESID_ROW(1, m, x1[m]);
#undef RESID_ROW
        { asm volatile("" ::: "memory"); }
    }
};
struct EpiQKV {
    static constexpr bool PERM = true, ZEROES = false;
    bf16_t* QKVb; const u64* ss; const float* qkg;
    __device__ __forceinline__ void operator()(const f32x4 (&acc)[2][2][4][2], const pg8::Unit& u, int wr, int wc, int fr, int fq) {
        float cfv[2][4];
        const int t = u.pn >> 3, row0 = u.pm * 256 + wr * 64 + fr, col0 = (u.pn & 7) * 256 + wc * 32 + 8 * fq;
        bf16_t* O = QKVb + (size_t)t * M * D;
        f32x4 ga = {1.f, 1.f, 1.f, 1.f}, gb = {1.f, 1.f, 1.f, 1.f};
#pragma unroll
        for (int ai = 0; ai < 2; ++ai)
#pragma unroll
            for (int m = 0; m < 4; ++m) cfv[ai][m] = row_cf(ss, ss, false, row0 + ai * 128 + m * 16);
        if (t < 2) { const float* gp = qkg + t * 64 + 8 * fq; ga = *(const f32x4*)gp; gb = *(const f32x4*)(gp + 4); if (t == 0) { ga = ga * QSCALE; gb = gb * QSCALE; } }
#pragma unroll
        for (int ai = 0; ai < 2; ++ai)
#pragma unroll
            for (int m = 0; m < 4; ++m) { const int r = row0 + ai * 128 + m * 16; const float cf = cfv[ai][m];
#pragma unroll
                for (int bj = 0; bj < 2; ++bj) { f32x4 v0 = acc[ai][bj][m][0] * cf, v1 = acc[ai][bj][m][1] * cf;
                    if (t < 2) { float q = (v0[0] * v0[0] + v0[1] * v0[1]) + (v0[2] * v0[2] + v0[3] * v0[3]) + (v1[0] * v1[0] + v1[1] * v1[1]) + (v1[2] * v1[2] + v1[3] * v1[3]);
                        q += __shfl_xor(q, 16); q += __shfl_xor(q, 32); const float hr = rsq(q * (1.0f / HD) + EPS); v0 = v0 * hr * ga; v1 = v1 * hr * gb; }
                    u32x4 w; w.x = cvt_pk_bf16(v0[0], v0[1]); w.y = cvt_pk_bf16(v0[2], v0[3]); w.z = cvt_pk_bf16(v1[0], v1[1]); w.w = cvt_pk_bf16(v1[2], v1[3]);
                    *(u32x4*)(O + (size_t)r * D + col0 + bj * 128) = w; } }
    }
};
struct EpiSguIn {
    static constexpr bool PERM = true, ZEROES = false;
    bf16_t* U; bf16_t* V; const u64* ss; u64* ssv;
    __device__ __forceinline__ void operator()(const f32x4 (&acc)[2][2][4][2], const pg8::Unit& u, int wr, int wc, int fr, int fq) {
        const int t = u.pn >> 4, row0 = u.pm * 256 + wr * 64 + fr, col0 = (u.pn & 15) * 256 + wc * 32 + 8 * fq;
        bf16_t* O = t ? V : U;
        float cfv[2][4];
#pragma unroll
        for (int ai = 0; ai < 2; ++ai)
#pragma unroll
            for (int m = 0; m < 4; ++m) cfv[ai][m] = row_cf(ss, ss, false, row0 + ai * 128 + m * 16);
#pragma unroll
        for (int ai = 0; ai < 2; ++ai)
#pragma unroll
            for (int m = 0; m < 4; ++m) { const int r = row0 + ai * 128 + m * 16; const float cf = cfv[ai][m]; float sv = 0.f;
#pragma unroll
                for (int bj = 0; bj < 2; ++bj) { const f32x4 v0 = acc[ai][bj][m][0] * cf, v1 = acc[ai][bj][m][1] * cf;
                    const f32x2 a = gelu_pk((f32x2){v0[0], v0[1]}), b = gelu_pk((f32x2){v0[2], v0[3]}), c = gelu_pk((f32x2){v1[0], v1[1]}), d = gelu_pk((f32x2){v1[2], v1[3]});
                    sv += (a.x * a.x + a.y * a.y) + (b.x * b.x + b.y * b.y) + (c.x * c.x + c.y * c.y) + (d.x * d.x + d.y * d.y);
                    u32x4 w; w.x = cvt_pk_bf16(a.x, a.y); w.y = cvt_pk_bf16(b.x, b.y); w.z = cvt_pk_bf16(c.x, c.y); w.w = cvt_pk_bf16(d.x, d.y);
                    *(u32x4*)(O + (size_t)r * DSGU + col0 + bj * 128) = w; }
                if (t) { sv += __shfl_xor(sv, 16); sv += __shfl_xor(sv, 32); if (fq == 0) stat_add(ssv, r, sv); } }
    }
};

constexpr size_t MiB = 1u << 20;
constexpr size_t WS_CTL = 0, CTL_ZERO_BYTES = 5 * MiB;
constexpr int CW_BAR = 1024;
constexpr size_t STAT_OFF = 65536;
constexpr int ST_F1 = 0, ST_S1 = 5, ST_MIX = 10, ST_F2 = 14, ST_V = 18, NSTAT = 19;
static_assert(STAT_OFF + (size_t)NSTAT * M * 8 <= CTL_ZERO_BYTES, "stats inside the memset region");
constexpr size_t WS_PAR = CTL_ZERO_BYTES;
constexpr int PAR_GOUT = 0, PAR_QG = 8192, PAR_KG = 8256  , PAR_RPB = 8320, PAR_VG = 67840, PAR_BS = 71936, PAR_WS = 73984, PAR_END = 336128;
static_assert(WS_PAR + (size_t)PAR_END * 4 <= 8 * MiB, "params region");
constexpr size_t WS_W = 8 * MiB;
constexpr size_t EL_FFN = (size_t)3 * D * DFF, EL_GU = (size_t)2 * D * DFF;
constexpr size_t EL_NA0 = 8 * EL_FFN, EL_NA = (size_t)4 * D * D, EL_QKV = (size_t)3 * D * D;
constexpr size_t EL_SGU = EL_NA0 + 2 * EL_NA, EL_SIN = (size_t)D * SGU_IN, EL_SOUT = (size_t)DSGU * D, EL_WS = (size_t)SGG * CHUNK * CHUNK;
constexpr size_t EL_POOL = EL_SGU + EL_SIN + EL_SOUT + EL_WS, EL_END = EL_POOL + (size_t)4 * PGD * PGD;
constexpr size_t WS_XB = WS_W + ((EL_END * 2 + MiB - 1) / MiB) * MiB;
constexpr size_t WS_BIG = WS_XB + (size_t)M * D * 2;
constexpr size_t WS_END = WS_BIG + 512 * MiB;

constexpr int RING_BYTES = 131072, MISC_OFF = RING_BYTES + 320, LDS_BYTES = 147456;

#define XB_TMO      128
#define XB_XCNT(j)  (256  + 64 * (j))
#define XB_XSUB(j)  (1280 + 64 * (j))
#define XB_XGEN(j)  (2304 + 64 * (j))
#define XB_TOP      3328
#define XB_TOPGEN   3392
#define XCD_BAR_WORDS 3456
#define XB_SPIN_CAP (1u << 18)
__device__ __forceinline__ unsigned xb_ld(unsigned* p)              { return __hip_atomic_load(p, __ATOMIC_RELAXED, __HIP_MEMORY_SCOPE_AGENT); }
__device__ __forceinline__ unsigned xb_add(unsigned* p, unsigned v) { return __hip_atomic_fetch_add(p, v, __ATOMIC_RELAXED, __HIP_MEMORY_SCOPE_AGENT); }
__device__ __forceinline__ unsigned xb_xcc_id() { return (unsigned)__builtin_amdgcn_s_getreg((3 << 11) | 20) & 0xFu; }
#define XB_SPIN(cond, bar) do { unsigned _sp = 0; while (cond) { __builtin_amdgcn_s_sleep(1); \
    if ((++_sp & 255u) == 0u) { if (xb_ld(&(bar)[XB_TMO])) break; if (_sp > XB_SPIN_CAP) { atomicAdd(&(bar)[XB_TMO], 1u); break; } } } } while (0)
struct XcdBarrier { unsigned* bar; unsigned x; volatile LAS unsigned* st; };
__device__ __forceinline__ XcdBarrier xcd_barrier_post(unsigned* bar, volatile LAS unsigned* st) {
    XcdBarrier b; b.bar = bar; b.x = xb_xcc_id(); b.st = st;
    if (threadIdx.x == 0) (void)xb_add(&bar[XB_XCNT(b.x)], 1u);
    return b;
}
__device__ __forceinline__ void xcd_barrier_complete(unsigned* bar, unsigned x, unsigned& nloc, unsigned& nx) {
    const unsigned G = gridDim.x * gridDim.y * gridDim.z;
    unsigned sum, cnt, mine, sp = 0u;
    for (;;) {
        sum = 0u; cnt = 0u; mine = 0u;
#pragma unroll
        for (unsigned j = 0; j < 16; ++j) { const unsigned c = xb_ld(&bar[XB_XCNT(j)]); sum += c; cnt += (c > 0u) ? 1u : 0u; mine = (j == x) ? c : mine; }
        if (sum == G) break;
        __builtin_amdgcn_s_sleep(1);
        if ((++sp & 255u) == 0u) { if (xb_ld(&bar[XB_TMO])) break; if (sp > XB_SPIN_CAP) { atomicAdd(&bar[XB_TMO], 1u); break; } }
    }
    nloc = mine > 0u ? mine : 1u; nx = cnt > 0u ? cnt : 1u;
}
__device__ __forceinline__ void xcd_barrier(const XcdBarrier& b) {
    asm volatile("s_waitcnt vmcnt(0)" ::: "memory");
    __syncthreads();
    if (threadIdx.x == 0) {
        unsigned* bar = b.bar;
        __builtin_amdgcn_s_waitcnt(0);
        unsigned nloc = b.st[0], nx = b.st[1];
        if (nloc == 0u) { xcd_barrier_complete(bar, b.x, nloc, nx); b.st[0] = nloc; b.st[1] = nx; }
        const unsigned old = xb_add(&bar[XB_XSUB(b.x)], 1u);
        const unsigned gen = old / nloc;
        if (old + 1u == (gen + 1u) * nloc) {
            __builtin_amdgcn_fence(__ATOMIC_RELEASE, "agent");
            asm volatile("s_waitcnt vmcnt(0)" ::: "memory");
            const unsigned og = xb_add(&bar[XB_TOP], 1u);
            const unsigned tg = og / nx;
            if (og + 1u == (tg + 1u) * nx) xb_add(&bar[XB_TOPGEN], 1u);
            else XB_SPIN(xb_ld(&bar[XB_TOPGEN]) == tg, bar);
            __builtin_amdgcn_fence(__ATOMIC_ACQUIRE, "agent");
            xb_add(&bar[XB_XGEN(b.x)], 1u);
            asm volatile("s_waitcnt vmcnt(0)" ::: "memory");
        } else {
            XB_SPIN(xb_ld(&bar[XB_XGEN(b.x)]) == gen, bar);
            __builtin_amdgcn_fence(__ATOMIC_ACQUIRE, "agent");
            asm volatile("s_waitcnt vmcnt(0)" ::: "memory");
        }
    }
    __syncthreads();
}

struct TrDesc { const float* W; bf16_t* WT; const float* gain; const float* nscale; float scale; int N, ldt, row_off, ilv, k0, n0; };
__device__ __forceinline__ void tr_set(TrDesc& d, const float* W, int K, int N, bf16_t* WT, int ldt, int row_off, int ilv, const float* gain, const float* nscale, float scale, int item) {
    const int nblk = N / 32, kb = item / nblk, nb = item % nblk; (void)K;
    d.W = W; d.WT = WT; d.gain = gain; d.nscale = nscale; d.scale = scale; d.N = N; d.ldt = ldt; d.row_off = row_off; d.ilv = ilv; d.k0 = 64 * kb; d.n0 = 32 * nb;
}
__device__ __forceinline__ void tr_load(const TrDesc& d, float (&v)[32], int lane) {
#pragma unroll
    for (int i = 0; i < 32; ++i) v[i] = d.W[(size_t)(d.k0 + 2 * i + (lane >> 5)) * d.N + d.n0 + (lane & 31)];
}
__device__ __forceinline__ void tr_store(const TrDesc& d, const float (&v)[32], LAS float* scr, int lane) {
    const float ns = (d.nscale ? d.nscale[d.n0 + (lane & 31)] : 1.0f) * d.scale;
#pragma unroll
    for (int i = 0; i < 32; ++i) { const int kk = 2 * i + (lane >> 5); const float gk = d.gain ? d.gain[d.k0 + kk] : 1.0f; scr[kk * 33 + (lane & 31)] = v[i] * (gk * ns); }
    asm volatile("s_waitcnt lgkmcnt(0)" ::: "memory");
    const int c = lane & 7;
    const int rbase = d.ilv < 0 ? d.row_off + d.n0 : (d.n0 >> 7) * 256 + d.ilv * 128 + (d.n0 & 127);
#pragma unroll
    for (int j = 0; j < 4; ++j) { const int n = (lane >> 3) + 8 * j; const LAS float* sp = scr + (8 * c) * 33 + n;
        u32x4 o; o.x = cvt_pk_bf16(sp[0 * 33], sp[1 * 33]); o.y = cvt_pk_bf16(sp[2 * 33], sp[3 * 33]); o.z = cvt_pk_bf16(sp[4 * 33], sp[5 * 33]); o.w = cvt_pk_bf16(sp[6 * 33], sp[7 * 33]);
        const int R = rbase + 16 * ((n >> 2) & 1) + 4 * (n >> 3) + (n & 3);
        *(u32x4*)(d.WT + ((size_t)(R >> 4) * (d.ldt >> 5) + (d.k0 >> 5) + (c >> 2)) * 512 + (R & 15) * 32 + 8 * (c & 3)) = o; }
    asm volatile("s_waitcnt lgkmcnt(0)" ::: "memory");
}

struct Args { const float* in[23]; float* out; unsigned char* ws; int ph_lo, ph_hi; };

__device__ __forceinline__ float wave_sum(float v) {
#pragma unroll
    for (int o = 1; o < 64; o <<= 1) v += __shfl_xor(v, o);
    return v;
}

__global__ void __launch_bounds__(512, 2) mega_fwd(Args a) {
    extern __shared__ __attribute__((aligned(16))) unsigned char lds_raw[];
    LAS unsigned char* lds = (LAS unsigned char*)lds_raw;
    volatile LAS unsigned* MISC = (volatile LAS unsigned*)(lds + MISC_OFF);
    const int tid = threadIdx.x, lane = tid & 63, wave = __builtin_amdgcn_readfirstlane(tid >> 6);
    const int G = gridDim.x, bx = blockIdx.x;
    const int vcu = (G % 8 == 0) ? (bx % 8) * (G / 8) + bx / 8 : bx;
    const int gw = vcu * 8 + wave, NGW = G * 8;
    unsigned char* ws = a.ws;
    unsigned* ctl = (unsigned*)(ws + WS_CTL);
    u64* stat = (u64*)(ws + STAT_OFF);
    float* par = (float*)(ws + WS_PAR);
    bf16_t* Wb = (bf16_t*)(ws + WS_W);
    bf16_t* XB = (bf16_t*)(ws + WS_XB);
    bf16_t* BIG = (bf16_t*)(ws + WS_BIG);
    float* X = a.out;
    for (int u = tid; u < (LDS_BYTES - RING_BYTES) / 4; u += 512) ((LAS unsigned*)(lds + RING_BYTES))[u] = 0u;
    __syncthreads();
    XcdBarrier bar = xcd_barrier_post(ctl + CW_BAR, MISC + 8);
    const int lo = a.ph_lo, hi = a.ph_hi;
    int pc = 0;
#ifndef PHMASK
#define PHMASK 0xffff
#endif
#define EN(k) (((PHMASK) >> (k)) & 1)
#define PH_ON (pc >= lo && pc < hi)
#define PH_END do { if (pc + 1 < hi) xcd_barrier(bar); } while (0)
#define STAT(i) (stat + (size_t)(i) * M)

    if (PH_ON && EN(0)) {
        LAS float* scr = (LAS float*)(lds + wave * 16384);
        constexpr int IT_FFN = 5632, N_FFN = 24 * IT_FFN, IT_QKV = 32 * 192, IT_WO = 32 * 64, IT_SIN = 32 * 256, IT_SOUT = 64 * 64, IT_POOL = 8 * 16;
        constexpr int N_ITEMS = N_FFN + 2 * (IT_QKV + IT_WO) + IT_SIN + IT_SOUT + 4 * IT_POOL;
#define TR_DECODE(IT, DD) do { int r = (IT); \
            if (r < N_FFN) { const int mat = r / IT_FFN, f = mat / 3, k = mat % 3, layer_ = f >> 1, which_ = f & 1; r -= mat * IT_FFN; bf16_t* base = Wb + (size_t)f * EL_FFN; \
                if (k < 2) tr_set(DD, a.in[(which_ ? 7 : 2) + k] + (size_t)layer_ * D * DFF, D, DFF, base, D, 0, k, a.in[which_ ? 6 : 1] + (size_t)layer_ * D, nullptr, 1.0f, r); \
                else tr_set(DD, a.in[which_ ? 9 : 4] + (size_t)layer_ * DFF * D, DFF, D, base + EL_GU, DFF, 0, -1, nullptr, nullptr, 0.5f, r); break; } \
            r -= N_FFN; \
            if (r < 2 * (IT_QKV + IT_WO)) { const int j = r / (IT_QKV + IT_WO); r -= j * (IT_QKV + IT_WO); \
                if (r < IT_QKV) tr_set(DD, a.in[11] + (size_t)j * D * NQKV, D, NQKV, Wb + EL_NA0 + j * EL_NA, D, 0, -1, a.in[5] + (size_t)(3 * j) * D, nullptr, 1.0f, r); \
                else tr_set(DD, a.in[15] + (size_t)j * D * D, D, D, Wb + EL_NA0 + j * EL_NA + EL_QKV, D, 0, -1, nullptr, nullptr, 1.0f, r - IT_QKV); break; } \
            r -= 2 * (IT_QKV + IT_WO); \
            if (r < IT_SIN) { tr_set(DD, a.in[16], D, SGU_IN, Wb + EL_SGU, D, 0, -1, a.in[5] + (size_t)1 * D, nullptr, 1.0f, r); break; } r -= IT_SIN; \
            if (r < IT_SOUT) { tr_set(DD, a.in[20], DSGU, D, Wb + EL_SGU + EL_SIN, DSGU, 0, -1, nullptr, nullptr, 1.0f, r); break; } r -= IT_SOUT; \
            { const int gp = r / IT_POOL; r -= gp * IT_POOL; \
              tr_set(DD, a.in[21] + (size_t)gp * PGD * PGD, PGD, PGD, Wb + EL_POOL, PGD, gp * PGD, -1, a.in[5] + (size_t)2 * D + gp * PGD, a.in[22] + gp * PGD, 1.0f, r); } } while (0)
        { TrDesc d0, d1; float v0[32], v1[32]; int it = gw; bool h0 = it < N_ITEMS;
          if (h0) { TR_DECODE(it, d0); tr_load(d0, v0, lane); }
          while (h0) {
              const int it1 = it + NGW; const bool h1 = it1 < N_ITEMS;
              if (h1) { TR_DECODE(it1, d1); tr_load(d1, v1, lane); }
              tr_store(d0, v0, scr, lane);
              if (!h1) break;
              it = it1 + NGW; h0 = it < N_ITEMS;
              if (h0) { TR_DECODE(it, d0); tr_load(d0, v0, lane); }
              tr_store(d1, v1, scr, lane);
          } }
#undef TR_DECODE
        { const float* wsrc = a.in[18]; bf16_t* wdst = Wb + EL_SGU + EL_SIN + EL_SOUT;
          for (int i = (gw * 64 + lane) * 2; i < (int)EL_WS; i += NGW * 128) *(unsigned*)(wdst + i) = cvt_pk_bf16(wsrc[i], wsrc[i + 1]); }
        { const int gt = gw * 64 + lane, NT = NGW * 64;
          for (int i = gt; i < 8192; i += NT) par[PAR_GOUT + i] = a.in[10][i];
          for (int i = gt; i < 64; i += NT) { par[PAR_QG + i] = a.in[12][i]; par[PAR_KG + i] = a.in[13][i]; }
          for (int i = gt; i < 59520; i += NT) par[PAR_RPB + i] = a.in[14][i] * LOG2E;
          for (int i = gt; i < 4096; i += NT) par[PAR_VG + i] = a.in[17][i];
          for (int i = gt; i < 2048; i += NT) par[PAR_BS + i] = a.in[19][i];
          for (int i = gt; i < 262144; i += NT) par[PAR_WS + i] = a.in[18][i]; }
        for (int m2 = gw; m2 < M / 2; m2 += NGW) {
            const int m = 2 * m2 + (lane >> 5), hl = lane & 31;
            const f32x4* xr = (const f32x4*)(a.in[0] + (size_t)m * D) + 2 * hl; bf16_t* bo = XB + xb_off(m, 8 * hl);
            float s = 0.f;
#pragma unroll
            for (int j = 0; j < 8; ++j) { const f32x4 v0 = xr[64 * j], v1 = xr[64 * j + 1];
                s += (v0[0] * v0[0] + v0[1] * v0[1]) + (v0[2] * v0[2] + v0[3] * v0[3]) + (v1[0] * v1[0] + v1[1] * v1[1]) + (v1[2] * v1[2] + v1[3] * v1[3]);
                u32x4 w; w.x = cvt_pk_bf16(v0[0], v0[1]); w.y = cvt_pk_bf16(v0[2], v0[3]); w.z = cvt_pk_bf16(v1[0], v1[1]); w.w = cvt_pk_bf16(v1[2], v1[3]); *(u32x4*)(bo + (size_t)j * 8 * 512) = w; }
#pragma unroll
            for (int o = 1; o < 32; o <<= 1) s += __shfl_xor(s, o);
            if (hl == 0) STAT(ST_F1 + 0)[m] = stat_fix(s);
        }
        PH_END;
    }
    ++pc;

    for (int step = 0; step < 2 * DEPTH; ++step) {
        const int layer = step >> 1, which = step & 1, kind = layer % 3, jm = layer / 3;
        if (which == 1) {
            if (kind == 0) {
                bf16_t* Q = BIG; bf16_t* Kb = BIG + (size_t)M * D; bf16_t* Vb = BIG + (size_t)2 * M * D; bf16_t* Ob = BIG + (size_t)3 * M * D;
                if (PH_ON && EN(6)) {

                    EpiQKV E{Q, STAT(ST_MIX + layer), par + PAR_QG + jm * HD};
                    pg8::gemm_phase<EpiQKV, pg8::Shape<NQKV, D, D, D, 0, 0, 8, 1>>(lds, XB, Wb + EL_NA0 + jm * EL_NA, G, bx, E);
                    PH_END;
                }
                ++pc;
                if (PH_ON && EN(2)) {
                    constexpr int VT_STRIDE = 1928, VT_OFF = 15 * 64 * 64, BI_OFF = VT_OFF + 32 * VT_STRIDE;
                    static_assert(BI_OFF + 529 * 4 <= RING_BYTES, "attention LDS");
                    int tq_ = threadIdx.x; asm volatile("" : "+v"(tq_));
                    const int tq = tq_, l = tq & 63, q = l & 15, g = l >> 4;
                    const float* rpbj = par + PAR_RPB + jm * NHEAD * 465;
                    for (int un = vcu; un < 2 * NHEAD * 32; un += G) {
                        const int h = un & 63, rb = (un >> 6) & 31, b = un >> 11;
                        const int R0 = rb * 8, KR0 = min(max(R0 - 4, 0), GROWS - 15);
                        const int r = R0 + wave, rs = min(max(r - 4, 0), GROWS - 8), krb = rs - KR0, drb = rs - r + 7;
                        bf16x8 qf[4];
#pragma unroll
                        for (int jb = 0; jb < 4; ++jb) qf[jb] = *(const bf16x8*)(Q + ((size_t)(b << 14) + r * 64 + 16 * jb + q) * D + h * 32 + 8 * g);
                        __syncthreads();
#pragma unroll
                        for (int e = 0; e < 4; ++e) { const int idx = tq + 512 * e;
                            if (idx < 15 * 32 * 4) { const int tok = (idx >> 2) * 2, ch = idx & 3; const size_t go = ((size_t)(b << 14) + KR0 * 64 + tok) * D + h * 32 + ch * 8;
                                const u32x4 ka = *(const u32x4*)(Kb + go), kb2 = *(const u32x4*)(Kb + go + D), va = *(const u32x4*)(Vb + go), vb = *(const u32x4*)(Vb + go + D);
                                *(LAS u32x4*)(lds + tok * 64 + ((ch ^ ((tok >> 2) & 3)) * 16)) = ka;
                                *(LAS u32x4*)(lds + (tok + 1) * 64 + ((ch ^ (((tok + 1) >> 2) & 3)) * 16)) = kb2;
                                LAS unsigned* vt = (LAS unsigned*)(lds + VT_OFF + (ch * 8) * VT_STRIDE + tok * 2); constexpr int VS = VT_STRIDE / 4;
                                vt[0 * VS] = (va.x & 0xffffu) | (vb.x << 16); vt[1 * VS] = (va.x >> 16) | (vb.x & 0xffff0000u); vt[2 * VS] = (va.y & 0xffffu) | (vb.y << 16); vt[3 * VS] = (va.y >> 16) | (vb.y & 0xffff0000u);
                                vt[4 * VS] = (va.z & 0xffffu) | (vb.z << 16); vt[5 * VS] = (va.z >> 16) | (vb.z & 0xffff0000u); vt[6 * VS] = (va.w & 0xffffu) | (vb.w << 16); vt[7 * VS] = (va.w >> 16) | (vb.w & 0xffff0000u); } }
                        if (tq < 529) ((LAS float*)(lds + BI_OFF))[tq] = (tq >= 32 && tq < 497) ? rpbj[h * 465 + tq - 32] : 0.f;
                        asm volatile("s_waitcnt vmcnt(0) lgkmcnt(0)" ::: "memory");
                        __syncthreads();
#pragma unroll 1
                        for (int jb = 0; jb < 4; ++jb) {
                            const int c = 16 * jb + q, cs = min(max(c - 8, 0), GRID_W - 16), kc0 = min(max(16 * jb - 8, 0), 32);
                            const int swz = (((kc0 >> 2) + (q >> 2)) & 3);
                            const bf16x8 qv = jb == 0 ? qf[0] : (jb == 1 ? qf[1] : (jb == 2 ? qf[2] : qf[3]));
                            f32x4 s[8][2];
#pragma unroll
                            for (int i = 0; i < 8; ++i)
#pragma unroll
                                for (int cb = 0; cb < 2; ++cb) { const int tokk = (krb + i) * 64 + kc0 + 16 * cb + q;
                                    const bf16x8 kf = *(const LAS bf16x8*)(lds + tokk * 64 + ((g ^ swz) * 16));
                                    s[i][cb] = __builtin_amdgcn_mfma_f32_16x16x32_bf16(kf, qv, (f32x4){0.f, 0.f, 0.f, 0.f}, 0, 0, 0); }
                            const int t = cs - kc0; bool sl[4]; const LAS float* blr[4];
                            const LAS float* bl = (const LAS float*)(lds + BI_OFF) + (32 + drb * 31 + kc0 + 4 * g - c + 15);
#pragma unroll
                            for (int rg = 0; rg < 4; ++rg) { sl[rg] = (4 * g + rg) >= t; blr[rg] = bl + (sl[rg] ? rg : 16 + rg); }
                            const unsigned m01 = (sl[0] ? 0xffffu : 0u) | (sl[1] ? 0xffff0000u : 0u), m23 = (sl[2] ? 0xffffu : 0u) | (sl[3] ? 0xffff0000u : 0u);
                            float mx = -1e30f;
#pragma unroll
                            for (int i = 0; i < 8; ++i)
#pragma unroll
                                for (int rg = 0; rg < 4; ++rg) { const float v = (sl[rg] ? s[i][0][rg] : s[i][1][rg]) + blr[rg][31 * i]; s[i][0][rg] = v; mx = fmaxf(mx, v); }
                            mx = fmaxf(mx, __shfl_xor(mx, 16)); mx = fmaxf(mx, __shfl_xor(mx, 32));
                            float sum = 0.f; bf16x8 pb[8];
#pragma unroll
                            for (int i = 0; i < 8; ++i) { float p[4];
#pragma unroll
                                for (int rg = 0; rg < 4; ++rg) { p[rg] = __builtin_amdgcn_exp2f(s[i][0][rg] - mx); sum += p[rg]; }
                                const unsigned p01 = cvt_pk_bf16(p[0], p[1]), p23 = cvt_pk_bf16(p[2], p[3]);
                                u32x4 w; w.x = p01 & m01; w.y = p23 & m23; w.z = p01 & ~m01; w.w = p23 & ~m23;
                                pb[i] = __builtin_bit_cast(bf16x8, w); }
                            sum += __shfl_xor(sum, 16); sum += __shfl_xor(sum, 32);
                            f32x4 o0 = {0.f, 0.f, 0.f, 0.f}, o1 = {0.f, 0.f, 0.f, 0.f};
#pragma unroll
                            for (int i = 0; i < 8; ++i) { const LAS unsigned char* vb = lds + VT_OFF + q * VT_STRIDE + ((krb + i) * 64 + kc0 + 4 * g) * 2;
                                const u32x2 a0 = *(const LAS u32x2*)(vb), a1 = *(const LAS u32x2*)(vb + 32), c0 = *(const LAS u32x2*)(vb + 16 * VT_STRIDE), c1 = *(const LAS u32x2*)(vb + 16 * VT_STRIDE + 32);
                                const bf16x8 va = __builtin_bit_cast(bf16x8, (u32x4){a0.x, a0.y, a1.x, a1.y}), vc = __builtin_bit_cast(bf16x8, (u32x4){c0.x, c0.y, c1.x, c1.y});
                                o0 = __builtin_amdgcn_mfma_f32_16x16x32_bf16(va, pb[i], o0, 0, 0, 0); o1 = __builtin_amdgcn_mfma_f32_16x16x32_bf16(vc, pb[i], o1, 0, 0, 0); }
                            const float inv = 1.0f / sum; bf16_t* op = Ob + ((size_t)(b << 14) + r * 64 + c) * D + h * 32 + 4 * g;
                            u32x2 w0v, w1v; w0v.x = cvt_pk_bf16(o0[0] * inv, o0[1] * inv); w0v.y = cvt_pk_bf16(o0[2] * inv, o0[3] * inv); w1v.x = cvt_pk_bf16(o1[0] * inv, o1[1] * inv); w1v.y = cvt_pk_bf16(o1[2] * inv, o1[3] * inv);
                            *(u32x2*)op = w0v; *(u32x2*)(op + 16) = w1v;
                        }
                    }
                    PH_END;
                }
                ++pc;
                if (PH_ON && EN(7)) {

                    EpiResid E{XB, STAT(ST_F2 + layer), false, STAT(ST_F2 + layer), nullptr, nullptr};
                    pg8::gemm_phase<EpiResid, pg8::Shape<D, D, D, D, 0, 0, 4>>(lds, Ob, Wb + EL_NA0 + jm * EL_NA + EL_QKV, G, bx, E);
                    PH_END;
                }
                ++pc;
            } else if (kind == 1) {
                bf16_t* U = BIG; bf16_t* V = BIG + (size_t)M * DSGU;
                if (PH_ON && EN(8)) {

                    EpiSguIn E{U, V, STAT(ST_MIX + layer), STAT(ST_V)};
                    pg8::gemm_phase<EpiSguIn, pg8::Shape<SGU_IN, D, D, D, 0, 0, 8, 1>>(lds, XB, Wb + EL_SGU, G, bx, E);
                    PH_END;
                }
                ++pc;

                if (PH_ON && EN(3)) {
                    constexpr int LSTR = 272, VN_OFF = 128 * LSTR;
                    static_assert(VN_OFF + 256 * LSTR <= RING_BYTES, "SGU LDS");
                    int tq_ = threadIdx.x; asm volatile("" : "+v"(tq_));
                    const int tq = tq_, l = tq & 63, q = l & 15, g = l >> 4;
                    const u64* ssv = STAT(ST_V);
                    const int gq = bx & 15;
                    if ((G & 15) == 0) {
                        const bf16_t* wsrc = Wb + EL_SGU + EL_SIN + EL_SOUT + (size_t)gq * CHUNK * CHUNK;
#pragma unroll
                        for (int e = 0; e < 4; ++e) { const int id = tq + 512 * e, i = id >> 4, cj = id & 15; *(LAS u32x4*)(lds + i * LSTR + cj * 16) = *(const u32x4*)(wsrc + i * CHUNK + cj * 8); }
                    }
                    for (int un = bx; un < (M / CHUNK) * SGG; un += G) {
                        const int n = un >> 4;
                        __syncthreads();
                        if ((G & 15) != 0) {
                            const bf16_t* wsrc = Wb + EL_SGU + EL_SIN + EL_SOUT + (size_t)(un & 15) * CHUNK * CHUNK;
#pragma unroll
                            for (int e = 0; e < 4; ++e) { const int id = tq + 512 * e, i = id >> 4, cj = id & 15; *(LAS u32x4*)(lds + i * LSTR + cj * 16) = *(const u32x4*)(wsrc + i * CHUNK + cj * 8); }
                        }
                        const int gu = un & 15;
#pragma unroll
                        for (int e = 0; e < 4; ++e) { const int id = tq + 512 * e, j = (id & 63) * 2, cc = id >> 6; const int tok = n * CHUNK + j;
                            const u32x4 va = *(const u32x4*)(V + (size_t)tok * DSGU + gu * SGD + cc * 8), vb = *(const u32x4*)(V + (size_t)(tok + 1) * DSGU + gu * SGD + cc * 8);
                            const float ra = rsq(stat_get(ssv, tok) * (1.0f / DSGU) + EPS), rb = rsq(stat_get(ssv, tok + 1) * (1.0f / DSGU) + EPS);
                            LAS unsigned* vt = (LAS unsigned*)(lds + VN_OFF + (cc * 8) * LSTR + j * 2); constexpr int VS = LSTR / 4;
#define B2_PAIR(dd, W) do { vt[(2 * dd) * VS] = cvt_pk_bf16(bflo(va.W) * ra, bflo(vb.W) * rb); vt[(2 * dd + 1) * VS] = cvt_pk_bf16(bfhi(va.W) * ra, bfhi(vb.W) * rb); } while (0)
                            B2_PAIR(0, x); B2_PAIR(1, y); B2_PAIR(2, z); B2_PAIR(3, w);
#undef B2_PAIR
                        }
                        asm volatile("s_waitcnt vmcnt(0) lgkmcnt(0)" ::: "memory");
                        __syncthreads();
                        f32x4 acc[2][8];
#pragma unroll
                        for (int ct = 0; ct < 2; ++ct)
#pragma unroll
                            for (int it = 0; it < 8; ++it) acc[ct][it] = (f32x4){0.f, 0.f, 0.f, 0.f};
#pragma unroll
                        for (int ks = 0; ks < 4; ++ks) {
                            const bf16x8 a0 = *(const LAS bf16x8*)(lds + VN_OFF + (32 * wave + q) * LSTR + (ks * 32 + 8 * g) * 2), a1 = *(const LAS bf16x8*)(lds + VN_OFF + (32 * wave + 16 + q) * LSTR + (ks * 32 + 8 * g) * 2);
#pragma unroll
                            for (int it = 0; it < 8; ++it) { const bf16x8 wf = *(const LAS bf16x8*)(lds + (16 * it + q) * LSTR + (ks * 32 + 8 * g) * 2);
                                acc[0][it] = __builtin_amdgcn_mfma_f32_16x16x32_bf16(a0, wf, acc[0][it], 0, 0, 0); acc[1][it] = __builtin_amdgcn_mfma_f32_16x16x32_bf16(a1, wf, acc[1][it], 0, 0, 0); }
                        }
#pragma unroll
                        for (int ct = 0; ct < 2; ++ct) { const int chb = gu * SGD + 32 * wave + 16 * ct + 4 * g; const f32x4 gn = *(const f32x4*)(par + PAR_VG + chb);
#pragma unroll
                            for (int it = 0; it < 8; ++it) { const int i = 16 * it + q; const float bs = par[PAR_BS + gu * CHUNK + i];
                                bf16_t* up = U + (size_t)(n * CHUNK + i) * DSGU + chb; const u32x2 uw = *(const u32x2*)up; const f32x4 a = acc[ct][it];
                                u32x2 w; w.x = cvt_pk_bf16(bflo(uw.x) * (gn[0] * a[0] + bs), bfhi(uw.x) * (gn[1] * a[1] + bs)); w.y = cvt_pk_bf16(bflo(uw.y) * (gn[2] * a[2] + bs), bfhi(uw.y) * (gn[3] * a[3] + bs));
                                *(u32x2*)up = w; } }
                    }
                    PH_END;
                }
                ++pc;
                if (PH_ON && EN(9)) {

                    EpiResid E{XB, STAT(ST_F2 + layer), false, STAT(ST_F2 + layer), nullptr, nullptr};
                    pg8::gemm_phase<EpiResid, pg8::Shape<D, DSGU, DSGU, DSGU, 0, 0, 4>>(lds, U, Wb + EL_SGU + EL_SIN, G, bx, E);
                    PH_END;
                }
                ++pc;
            } else {
                bf16_t* P = BIG;
                if (PH_ON && EN(4)) {
                    const u64* ssm = STAT(ST_MIX + layer);
                    const int gi = lane >> 4, hw = 1 << gi;
#define POOL_ROW(ROWT, WGT, OP) do { const int sx_ = (ROWT); const bool in_ = (sx_ >= 0) && (sx_ < SEQ) && (WGT); const int row_ = (b << 14) + min(max(sx_, 0), SEQ - 1); \
        const float rs_ = in_ ? rsq(stat_get(ssm, row_) * (1.0f / D) + EPS) : 0.f; const u32x4* xp_ = (const u32x4*)(XB + xb_off(row_, lane * 32)); \
        _Pragma("unroll") for (int e = 0; e < 4; ++e) { const u32x4 w_ = xp_[e]; \
            sum[8 * e + 0] OP bflo(w_.x) * rs_; sum[8 * e + 1] OP bfhi(w_.x) * rs_; sum[8 * e + 2] OP bflo(w_.y) * rs_; sum[8 * e + 3] OP bfhi(w_.y) * rs_; \
            sum[8 * e + 4] OP bflo(w_.z) * rs_; sum[8 * e + 5] OP bfhi(w_.z) * rs_; sum[8 * e + 6] OP bflo(w_.w) * rs_; sum[8 * e + 7] OP bfhi(w_.w) * rs_; } } while (0)
                    for (int run = gw; run < M / 16; run += NGW) {
                        const int t0 = run * 16, b = t0 >> 14, tt0 = t0 & 16383;
                        float sum[32];
#pragma unroll
                        for (int e = 0; e < 32; ++e) sum[e] = 0.f;
#pragma unroll 4
                        for (int off = -8; off < 8; ++off) POOL_ROW(tt0 + off, (off >= -hw) && (off < hw), +=);
#pragma unroll 2
                        for (int k = 0; k < 16; ++k) {
                            const int tt = tt0 + k, t = t0 + k;
                            const float ic = 1.0f / (float)(min(tt + hw, SEQ) - max(tt - hw, 0)), rst = rsq(stat_get(ssm, t) * (1.0f / D) + EPS);
                            const u32x4* xs = (const u32x4*)(XB + xb_off(t, lane * 32)); u32x4* pp = (u32x4*)(P + (size_t)t * D + lane * 32);
#pragma unroll
                            for (int e = 0; e < 4; ++e) { const u32x4 x = xs[e]; u32x4 w;
                                w.x = cvt_pk_bf16(sum[8 * e + 0] * ic - bflo(x.x) * rst, sum[8 * e + 1] * ic - bfhi(x.x) * rst); w.y = cvt_pk_bf16(sum[8 * e + 2] * ic - bflo(x.y) * rst, sum[8 * e + 3] * ic - bfhi(x.y) * rst);
                                w.z = cvt_pk_bf16(sum[8 * e + 4] * ic - bflo(x.z) * rst, sum[8 * e + 5] * ic - bfhi(x.z) * rst); w.w = cvt_pk_bf16(sum[8 * e + 6] * ic - bflo(x.w) * rst, sum[8 * e + 7] * ic - bfhi(x.w) * rst); pp[e] = w; }
                            POOL_ROW(tt + hw, true, +=);
                            POOL_ROW(tt - hw, true, -=);
                        }
                    }
#undef POOL_ROW
                    PH_END;
                }
                ++pc;
                if (PH_ON && EN(10)) {

                    EpiResid E{XB, STAT(ST_F2 + layer), false, STAT(ST_F2 + layer), nullptr, nullptr};
                    pg8::gemm_phase<EpiResid, pg8::Shape<D, PGD, D, PGD, 2, PGD * 2>>(lds, P, Wb + EL_POOL, G, bx, E);
                    PH_END;
                }
                ++pc;
            }
        }
        bf16_t* H = BIG;
        const bf16_t* Wf = Wb + (size_t)step * EL_FFN;
        if (PH_ON && EN(11)) {

            EpiSwiGLU E{H, which ? STAT(ST_F2 + layer) : STAT(ST_F1 + layer), STAT(ST_S1 + layer), (which == 0 && layer > 0), -1, {}};
            pg8::gemm_phase<EpiSwiGLU, pg8::Shape<2 * DFF, D, D, D, 0, 0, 8, 1>>(lds, XB, Wf, G, bx, E);
            PH_END;
        }
        ++pc;

        if (PH_ON && EN(12)) {

            EpiResid E{XB, STAT(ST_S1 + layer), (which == 0 && layer > 0), which ? STAT(ST_F1 + layer + 1) : STAT(ST_MIX + layer),
                       which ? par + PAR_GOUT + layer * D : nullptr, which ? STAT(ST_S1 + layer + 1) : nullptr};
            pg8::gemm_phase<EpiResid, pg8::Shape<D, DFF, DFF, DFF, 0, 0, 4, 1>>(lds, H, Wf + EL_GU, G, bx, E);
            PH_END;
        }
        ++pc;
    }
    if (PH_ON && EN(5)) {
        const u64* s1 = STAT(ST_S1 + DEPTH);
        for (int m2 = gw; m2 < M / 2; m2 += NGW) { const int m = 2 * m2 + (lane >> 5), hl = lane & 31;
            const float ps = rsq(stat_get(s1, m) * (1.0f / D) + EPS); f32x4* xo = (f32x4*)(X + (size_t)m * D) + 2 * hl; const bf16_t* xb = XB + xb_off(m, 8 * hl);
#pragma unroll
            for (int j = 0; j < 8; ++j) { const u32x4 w = *(const u32x4*)(xb + (size_t)j * 8 * 512);
                xo[64 * j] = (f32x4){bflo(w.x), bfhi(w.x), bflo(w.y), bfhi(w.y)} * ps; xo[64 * j + 1] = (f32x4){bflo(w.z), bfhi(w.z), bflo(w.w), bfhi(w.w)} * ps; } }
    }
    ++pc;
}

constexpr int N_PHASES = 1 + DEPTH * 4 + 3 + 3 + 2 + 3 + 1;
#ifndef MK_PER_PHASE
#define MK_PER_PHASE 0
#endif

extern "C" void kernel_launch(void* const* d_in, const int* in_sizes, int n_in, void* d_out, int out_size, void* d_ws, size_t ws_size, hipStream_t stream) {
    static int grid = 0;
    if (grid == 0) {
        if (n_in != 23 || in_sizes[0] != M * D || out_size != M * D || ws_size < WS_END) { fprintf(stderr, "kernel_launch: unexpected problem (n_in %d, in0 %d, out %d, ws %zu < %zu)\n", n_in, n_in > 0 ? in_sizes[0] : -1, out_size, ws_size, (size_t)WS_END); grid = -1; return; }
        int dev = 0, cus = 0, per_cu = 0;
        if (hipGetDevice(&dev) != hipSuccess || hipDeviceGetAttribute(&cus, hipDeviceAttributeMultiprocessorCount, dev) != hipSuccess) { grid = -1; return; }
        if (hipFuncSetAttribute((const void*)mega_fwd, hipFuncAttributeMaxDynamicSharedMemorySize, LDS_BYTES) != hipSuccess) { fprintf(stderr, "kernel_launch: hipFuncSetAttribute failed\n"); grid = -1; return; }
        if (hipOccupancyMaxActiveBlocksPerMultiprocessor(&per_cu, (const void*)mega_fwd, 512, LDS_BYTES) != hipSuccess || per_cu < 1) fprintf(stderr, "kernel_launch: occupancy query says %d\n", per_cu);
        (void)hipGetLastError();
        grid = cus;
    }
    if (grid < 0) return;
    (void)hipMemsetAsync((char*)d_ws + WS_CTL, 0, CTL_ZERO_BYTES, stream);
    Args a{};
    for (int i = 0; i < 23; ++i) a.in[i] = (const float*)d_in[i];
    a.out = (float*)d_out; a.ws = (unsigned char*)d_ws;
#if MK_PER_PHASE
    for (int p = 0; p < N_PHASES; ++p) { a.ph_lo = p; a.ph_hi = p + 1; hipLaunchKernelGGL(mega_fwd, dim3(grid), dim3(512), LDS_BYTES, stream, a); }
#else
    a.ph_lo = 0; a.ph_hi = N_PHASES;
    hipLaunchKernelGGL(mega_fwd, dim3(grid), dim3(512), LDS_BYTES, stream, a);
#endif
}
```

```cpp
#include <hip/hip_runtime.h>
#include <cstdio>
#include <cstdint>

constexpr int D = 2048, SEQ = 16384, M = 32768, DEPTH = 4, DFF = 5632;
constexpr int NHEAD = 64, HD = 32, GRID_W = 64, GROWS = 256, NQKV = 3 * D;
constexpr int DSGU = 4096, SGU_IN = 8192, CHUNK = 128, SGG = 16, SGD = 256;
constexpr int PGD = 512;
constexpr float EPS = 1e-6f;
constexpr float LOG2E = 1.4426950408889634f;
constexpr float QSCALE = 0.17677669529663687f * LOG2E;

typedef unsigned short bf16_t;
#define LAS __attribute__((address_space(3)))
#define GAS __attribute__((address_space(1)))
typedef short bf16x8 __attribute__((ext_vector_type(8)));
typedef float f32x4 __attribute__((ext_vector_type(4)));
typedef float f32x2 __attribute__((ext_vector_type(2)));
typedef unsigned u32x4 __attribute__((ext_vector_type(4)));
typedef unsigned u32x2 __attribute__((ext_vector_type(2)));

__device__ __forceinline__ unsigned cvt_pk_bf16(float lo, float hi) { unsigned r; asm volatile("v_cvt_pk_bf16_f32 %0, %1, %2" : "=v"(r) : "v"(lo), "v"(hi)); return r; }
__device__ __forceinline__ float bflo(unsigned w) { return __uint_as_float(w << 16); }
__device__ __forceinline__ float bfhi(unsigned w) { return __uint_as_float(w & 0xffff0000u); }
__device__ __forceinline__ float bf2f(bf16_t b) { return __uint_as_float(((unsigned)b) << 16); }
__device__ __forceinline__ float rsq(float x) { return __builtin_amdgcn_rsqf(x); }
typedef unsigned long long u64;
constexpr float STAT_SCALE = 4194304.0f, STAT_INV = 1.0f / 4194304.0f;
__device__ __forceinline__ u64 stat_fix(float s) { return (u64)(long long)__float2ll_rn(s * STAT_SCALE); }
__device__ __forceinline__ float stat_f(u64 v) { return ((float)(unsigned)(v >> 32) * 4294967296.0f + (float)(unsigned)v) * STAT_INV; }
__device__ __forceinline__ float stat_get(const u64* p, int r) { return stat_f(p[r]); }
__device__ __forceinline__ void stat_add(u64* p, int r, float s) { atomicAdd(p + r, stat_fix(s)); }

#ifndef PG8_PRIO
#define PG8_PRIO 1
#endif
#ifndef PG8_SP2
#define PG8_SP2 1
#endif
namespace pg8 {
constexpr int BM = 256, BK = 64, HALF = 128, HTB = HALF * BK * 2, STAGE_BYTES = 8 * HTB, NXCD = 8, WGM = 8;
__host__ __device__ __forceinline__ int lds_byte(int r, int c) { const int st = (r >> 4) * 2 + (c >> 5), rr = r & 15, cc = c & 31, ob = rr * 64 + cc * 2; return st * 1024 + (ob ^ (((ob >> 9) & 1) << 5)); }
__host__ __device__ __forceinline__ void stage_rc(int b, int& R, int& C) { const int st = b / 1024, sb = b % 1024, swz = sb ^ (((sb >> 9) & 1) << 5); R = (st >> 1) * 16 + swz / 64; C = (st & 1) * 32 + (swz % 64) / 2; }
__host__ __device__ __forceinline__ int perm32(int rho) { const int n = rho >> 4, i = rho & 15; return 8 * (i >> 2) + 4 * n + (i & 3); }

struct Unit { int pm, pn; };
template <int N_, int K_, int LDA_, int LDB_, int GT_ = 0, int GAB_ = 0, int WGM_ = 8, int ATILE_ = 0> struct Shape { static constexpr int N = N_, K = K_, LDA = LDA_, LDB = LDB_, GT = GT_, GAB = GAB_, WGMS = WGM_, ATILE = ATILE_; };

template <int nM, int nN, int WGMS> struct StaticOrder {
    int G, c;
    __device__ __forceinline__ bool next(int i, Unit& u) const {
        constexpr int nwg = nM * nN;
        const int L = i * G + c; if (L >= nwg) return false;
        int wgid = L; { constexpr int q = nwg / NXCD, r = nwg % NXCD; const int xcd = wgid % NXCD, off = wgid / NXCD; wgid = (xcd < r ? xcd * (q + 1) : r * (q + 1) + (xcd - r) * q) + off; }
        constexpr int nig = WGMS * nN; const int gid = wgid / nig, fm = gid * WGMS, gsz = (nM - fm) < WGMS ? (nM - fm) : WGMS;
        u.pm = fm + ((wgid % nig) % gsz); u.pn = (wgid % nig) / gsz; return true;
    }
};

template <class Epi, class SH>
__device__ __forceinline__ void gemm_phase(LAS unsigned char* lds, const bf16_t* gA, const bf16_t* gBt, int G_, int c_, Epi& E) {
    StaticOrder<32768 / BM, SH::N / BM, SH::WGMS> S; S.G = G_; S.c = c_;
    int tid_ = threadIdx.x; asm volatile("" : "+v"(tid_));
    const int tid = tid_, wid = __builtin_amdgcn_readfirstlane(tid >> 6), lane = tid & 63, wr = wid >> 2, wc = wid & 3, fr = lane & 15, fq = lane >> 4;
    constexpr int nt = SH::K / BK;
    unsigned voffA[2], voffB[2];
#pragma unroll
    for (int i = 0; i < 2; ++i) { int R, C; stage_rc(tid * 16 + i * 8192, R, C); const int Rb = Epi::PERM ? ((R & ~31) + perm32(R & 31)) : R;
        voffA[i] = SH::ATILE ? (unsigned)(((R >> 4) * (SH::LDA / 32) + (C >> 5)) * 1024 + (R & 15) * 64 + (C & 31) * 2) : (unsigned)(R * SH::LDA + C) * 2u;
        static_assert(Epi::PERM, "the weight copies are stored pre-permuted"); (void)Rb;
        voffB[i] = (unsigned)(((R >> 4) * (SH::LDB / 32) + (C >> 5)) * 1024 + (R & 15) * 64 + (C & 31) * 2); }
    const unsigned kstep = 2048u, kstepA = SH::ATILE ? 2048u : (unsigned)(BK * 2);
    constexpr unsigned hA = (unsigned)HALF * SH::LDA * 2, hB = (unsigned)HALF * SH::LDB * 2, tA = 2 * hA, tB = 2 * hB;
    const __amdgpu_buffer_rsrc_t rsA = __builtin_amdgcn_make_buffer_rsrc((void*)gA, 0, -1, 0x00020000), rsB = __builtin_amdgcn_make_buffer_rsrc((void*)gBt, 0, -1, 0x00020000);
    const unsigned ldsw = (unsigned)wid * 1024u;
    const int aoff = lds_byte(wr * 64 + fr, fq * 8), boff = lds_byte(wc * 32 + fr, fq * 8);
#define PG8_APTR(u) ((unsigned)(u).pm * tA + (SH::GT ? (unsigned)((u).pn / (SH::GT ? SH::GT : 1)) * (unsigned)SH::GAB : 0u))
#define PG8_BPTR(u) ((unsigned)(u).pn * tB)
#define PG8_RS_voffA rsA
#define PG8_RS_voffB rsB
#define PG8_SA(b, h) (((b) * 2 + (h)) * HTB)
#define PG8_SB(b, h) ((4 + (b) * 2 + (h)) * HTB)
#define PG8_STAGE(bufoff, gbase, voff) do { _Pragma("unroll") for (int _i = 0; _i < 2; ++_i) \
        __builtin_amdgcn_raw_ptr_buffer_load_lds(PG8_RS_##voff, (LAS unsigned*)(lds + (bufoff) + ldsw + _i * 8192), 16, (int)(voff)[_i], (int)(gbase), 0, 0); } while (0)
#define PG8_LDA(dst, b, h) do { _Pragma("unroll") for (int m = 0; m < 4; ++m) _Pragma("unroll") for (int k = 0; k < 2; ++k) dst[m][k] = *(const LAS bf16x8*)(lds + PG8_SA(b, h) + aoff + m * 2048 + k * 1024); } while (0)
#define PG8_LDB(dst, b, h) do { _Pragma("unroll") for (int n = 0; n < 2; ++n) _Pragma("unroll") for (int k = 0; k < 2; ++k) dst[n][k] = *(const LAS bf16x8*)(lds + PG8_SB(b, h) + boff + n * 2048 + k * 1024); } while (0)
#define PG8_MMA(ai, bj, At, Bt) do { if (PG8_PRIO) __builtin_amdgcn_s_setprio(1); _Pragma("unroll") for (int m = 0; m < 4; ++m) _Pragma("unroll") for (int n = 0; n < 2; ++n) _Pragma("unroll") for (int k = 0; k < 2; ++k) \
        acc[ai][bj][m][n] = __builtin_amdgcn_mfma_f32_16x16x32_bf16(Bt[n][k], At[m][k], acc[ai][bj][m][n], 0, 0, 0); if (PG8_PRIO) __builtin_amdgcn_s_setprio(0); } while (0)
#define PG8_WAIT_V(n) asm volatile("s_waitcnt vmcnt(" #n ")" ::: "memory")
#define PG8_WAIT_L(n) asm volatile("s_waitcnt lgkmcnt(" #n ")" ::: "memory")
#define PG8_BAR __builtin_amdgcn_s_barrier()
#define PG8_SCHED __builtin_amdgcn_sched_barrier(0)
    Unit cur, nxt; int ui = 0;
    if (!S.next(0, cur)) return;
    f32x4 acc[2][2][4][2];
#pragma unroll
    for (int a = 0; a < 2; ++a)
#pragma unroll
        for (int b = 0; b < 2; ++b)
#pragma unroll
            for (int m = 0; m < 4; ++m)
#pragma unroll
                for (int n = 0; n < 2; ++n) acc[a][b][m][n] = (f32x4){0.f, 0.f, 0.f, 0.f};
    bf16x8 At[4][2], B0[2][2], B1[2][2];
    unsigned cA = PG8_APTR(cur), cB = PG8_BPTR(cur);
#if PG8_SP2
    PG8_STAGE(PG8_SB(0, 0), cB, voffB); PG8_STAGE(PG8_SB(0, 1), cB + hB, voffB); PG8_STAGE(PG8_SA(0, 0), cA, voffA); PG8_STAGE(PG8_SA(0, 1), cA + hA, voffA);
    if (wr == 1) PG8_BAR;
    PG8_WAIT_V(2); PG8_BAR;
    PG8_STAGE(PG8_SB(1, 0), cB + kstep, voffB); PG8_STAGE(PG8_SA(1, 0), cA + kstepA, voffA); PG8_STAGE(PG8_SB(1, 1), cB + hB + kstep, voffB);
    PG8_WAIT_V(6); PG8_BAR;
#else
    PG8_STAGE(PG8_SB(0, 0), cB, voffB); PG8_STAGE(PG8_SA(0, 0), cA, voffA); PG8_STAGE(PG8_SB(0, 1), cB + hB, voffB); PG8_STAGE(PG8_SA(0, 1), cA + hA, voffA);
    if (wr == 1) PG8_BAR;
    PG8_WAIT_V(4); PG8_BAR;
    PG8_STAGE(PG8_SB(1, 0), cB + kstep, voffB); PG8_STAGE(PG8_SA(1, 0), cA + kstepA, voffA); PG8_STAGE(PG8_SB(1, 1), cB + hB + kstep, voffB);
    PG8_WAIT_V(6); PG8_BAR;
#endif
    for (;;) {
        const bool has_next = S.next(ui + 1, nxt);
        const unsigned nA = has_next ? PG8_APTR(nxt) : cA, nB = has_next ? PG8_BPTR(nxt) : cB;
        for (int t = 0; t < nt; t += 2) {
            const bool last = (t == nt - 2);
            const unsigned a1 = cA + (unsigned)(t + 1) * kstepA;
            const unsigned a2 = last ? nA : cA + (unsigned)(t + 2) * kstepA, b2 = last ? nB : cB + (unsigned)(t + 2) * kstep;
            const unsigned a3 = a2 + kstepA, b3 = b2 + kstep;
#if PG8_SP2
            PG8_LDB(B0, 0, 0); PG8_LDB(B1, 0, 1); PG8_SCHED; PG8_LDA(At, 0, 0); PG8_STAGE(PG8_SA(1, 1), a1 + hA, voffA);
            PG8_WAIT_V(8); PG8_WAIT_L(0); PG8_BAR; PG8_MMA(0, 0, At, B0); PG8_MMA(0, 1, At, B1); PG8_BAR; PG8_SCHED;
            PG8_LDA(At, 0, 1); PG8_STAGE(PG8_SB(0, 0), b2, voffB); PG8_STAGE(PG8_SB(0, 1), b2 + hB, voffB); PG8_STAGE(PG8_SA(0, 0), a2, voffA);
            PG8_WAIT_V(8); PG8_WAIT_L(0); PG8_BAR; PG8_MMA(1, 0, At, B0); PG8_MMA(1, 1, At, B1); PG8_BAR; PG8_SCHED;
            PG8_LDB(B0, 1, 0); PG8_LDB(B1, 1, 1); PG8_SCHED; PG8_LDA(At, 1, 0); PG8_STAGE(PG8_SA(0, 1), a2 + hA, voffA);
            PG8_WAIT_V(8); PG8_WAIT_L(0); PG8_BAR; PG8_MMA(0, 0, At, B0); PG8_MMA(0, 1, At, B1); PG8_BAR; PG8_SCHED;
            PG8_LDA(At, 1, 1); PG8_STAGE(PG8_SB(1, 0), b3, voffB); PG8_STAGE(PG8_SB(1, 1), b3 + hB, voffB); PG8_STAGE(PG8_SA(1, 0), a3, voffA);
            PG8_WAIT_V(8); PG8_WAIT_L(0); PG8_BAR; PG8_MMA(1, 0, At, B0); PG8_MMA(1, 1, At, B1); PG8_BAR; PG8_SCHED;
#else
            PG8_LDB(B0, 0, 0); PG8_SCHED; PG8_LDA(At, 0, 0); PG8_STAGE(PG8_SA(1, 1), a1 + hA, voffA);
            PG8_WAIT_L(8); PG8_BAR; PG8_WAIT_L(0); PG8_MMA(0, 0, At, B0); PG8_BAR; PG8_SCHED;
            PG8_LDB(B1, 0, 1); PG8_STAGE(PG8_SB(0, 0), b2, voffB);
            PG8_BAR; PG8_WAIT_L(0); PG8_MMA(0, 1, At, B1); PG8_BAR;
            PG8_LDA(At, 0, 1); PG8_STAGE(PG8_SA(0, 0), a2, voffA);
            PG8_BAR; PG8_WAIT_L(0); PG8_MMA(1, 0, At, B0); PG8_BAR; PG8_SCHED;
            PG8_STAGE(PG8_SB(0, 1), b2 + hB, voffB);
            PG8_WAIT_V(6); PG8_BAR; PG8_MMA(1, 1, At, B1); PG8_BAR;
            PG8_LDB(B0, 1, 0); PG8_SCHED; PG8_LDA(At, 1, 0); PG8_STAGE(PG8_SA(0, 1), a2 + hA, voffA);
            PG8_WAIT_L(8); PG8_BAR; PG8_WAIT_L(0); PG8_MMA(0, 0, At, B0); PG8_BAR; PG8_SCHED;
            PG8_LDB(B1, 1, 1); PG8_STAGE(PG8_SB(1, 0), b3, voffB);
            PG8_BAR; PG8_WAIT_L(0); PG8_MMA(0, 1, At, B1); PG8_BAR;
            PG8_LDA(At, 1, 1); PG8_STAGE(PG8_SA(1, 0), a3, voffA);
            PG8_BAR; PG8_WAIT_L(0); PG8_MMA(1, 0, At, B0); PG8_BAR; PG8_SCHED;
            PG8_STAGE(PG8_SB(1, 1), b3 + hB, voffB);
            PG8_WAIT_V(6); PG8_BAR; PG8_MMA(1, 1, At, B1); PG8_BAR;
#endif
        }
        if (wr == 0) PG8_BAR;
        E(acc, cur, wr, wc, fr, fq);
        if (!has_next) break;
        if (!Epi::ZEROES)
#pragma unroll
        for (int a = 0; a < 2; ++a)
#pragma unroll
            for (int b = 0; b < 2; ++b)
#pragma unroll
                for (int m = 0; m < 4; ++m)
#pragma unroll
                    for (int n = 0; n < 2; ++n) { double z0, z1; asm volatile("v_mov_b64 %0, 0" : "=v"(z0)); asm volatile("v_mov_b64 %0, 0" : "=v"(z1));
                        const f32x2 l = __builtin_bit_cast(f32x2, z0), h = __builtin_bit_cast(f32x2, z1); acc[a][b][m][n] = (f32x4){l.x, l.y, h.x, h.y}; }
        cur = nxt; cA = nA; cB = nB; ++ui;
        if (wr == 1) PG8_BAR;
    }
    PG8_WAIT_V(0);
    PG8_BAR;
#undef PG8_APTR
#undef PG8_BPTR
#undef PG8_RS_voffA
#undef PG8_RS_voffB
#undef PG8_SA
#undef PG8_SB
#undef PG8_STAGE
#undef PG8_LDA
#undef PG8_LDB
#undef PG8_MMA
#undef PG8_WAIT_V
#undef PG8_WAIT_L
#undef PG8_BAR
#undef PG8_SCHED
}
}

__device__ __forceinline__ f32x2 gelu_pk(f32x2 v) {
    const f32x2 av = __builtin_elementwise_abs(v), d = av * 0.2316418882f + 1.0f;
    f32x2 t; t.x = __builtin_amdgcn_rcpf(d.x); t.y = __builtin_amdgcn_rcpf(d.y);
    f32x2 q = t * 0.5307027145f + (-0.7265760135f); q = q * t + 0.7107068705f; q = q * t + (-0.142248368f); q = q * t + 0.127414796f; q = q * t;
    const f32x2 s = (v * v) * (-0.72134752044f);
    f32x2 e; e.x = __builtin_amdgcn_exp2f(s.x); e.y = __builtin_amdgcn_exp2f(s.y);
    const f32x2 m = v * (q * e), r = v - m;
    f32x2 o; o.x = v.x < 0.f ? m.x : r.x; o.y = v.y < 0.f ? m.y : r.y; return o;
}
__device__ __forceinline__ float silu_f(float x) { return x * __builtin_amdgcn_rcpf(1.0f + __builtin_amdgcn_exp2f(-LOG2E * x)); }

__device__ __forceinline__ float row_ps(const u64* s1, bool has1, int r) { const float p = rsq(stat_f(s1[r]) * (1.0f / D) + EPS); return has1 ? p : 1.0f; }
__device__ __forceinline__ float row_cf(const u64* ss, const u64* s1, bool has1, int r) { const float ps = row_ps(s1, has1, r); return ps * rsq(ps * ps * stat_f(ss[r]) * (1.0f / D) + EPS); }

struct EpiSwiGLU {
    static constexpr bool PERM = true, ZEROES = true;
    bf16_t* O; const u64* ss; const u64* s1; bool has1; int cf_pm; float cfv[2][4];
    __device__ __forceinline__ void operator()(f32x4 (&acc)[2][2][4][2], const pg8::Unit& u, int wr, int wc, int fr, int fq) {
        const int row0 = u.pm * 256 + wr * 64 + fr;
        if (u.pm != cf_pm) { cf_pm = u.pm;
#pragma unroll
        for (int ai = 0; ai < 2; ++ai)
#pragma unroll
            for (int m = 0; m < 4; ++m) cfv[ai][m] = row_cf(ss, s1, has1, row0 + ai * 128 + m * 16); }
        char* const obase = (char*)O + ((size_t)(u.pm * 16 + wr * 4) * (DFF / 32) + u.pn * 4 + wc) * 1024 + fr * 64 + fq * 16;
#pragma unroll
        for (int ai = 0; ai < 2; ++ai)
#pragma unroll
            for (int m = 0; m < 4; ++m) { const float cf = cfv[ai][m], c1 = -LOG2E * cf, ic2 = __builtin_amdgcn_rcpf(cf * cf);
                u32x4 w;
#pragma unroll
                for (int n = 0; n < 2; ++n) { const f32x4 g = acc[ai][0][m][n], uu = acc[ai][1][m][n];
                    const f32x2 ga = {g[0], g[1]}, gb = {g[2], g[3]}, ua = {uu[0], uu[1]}, ub = {uu[2], uu[3]};
                    const f32x2 ta = ga * c1, tb = gb * c1; f32x2 ea, eb; ea.x = __builtin_amdgcn_exp2f(fminf(ta.x, 40.f)); ea.y = __builtin_amdgcn_exp2f(fminf(ta.y, 40.f)); eb.x = __builtin_amdgcn_exp2f(fminf(tb.x, 40.f)); eb.y = __builtin_amdgcn_exp2f(fminf(tb.y, 40.f));
                    const f32x2 da = ea * ic2 + ic2, db = eb * ic2 + ic2, pp = da * db; f32x2 rr; rr.x = __builtin_amdgcn_rcpf(pp.x); rr.y = __builtin_amdgcn_rcpf(pp.y);
                    const f32x2 oa = (ga * ua) * (rr * db), ob = (gb * ub) * (rr * da);
                    if (n == 0) { w.x = cvt_pk_bf16(oa.x, oa.y); w.y = cvt_pk_bf16(ob.x, ob.y); } else { w.z = cvt_pk_bf16(oa.x, oa.y); w.w = cvt_pk_bf16(ob.x, ob.y); } }
                __builtin_nontemporal_store(w, (u32x4*)(obase + (size_t)(ai * 8 + m) * (DFF / 32) * 1024));
#pragma unroll
                for (int bj = 0; bj < 2; ++bj)
#pragma unroll
                    for (int n = 0; n < 2; ++n) { double z0, z1; asm volatile("v_mov_b64 %0, 0" : "=v"(z0)); asm volatile("v_mov_b64 %0, 0" : "=v"(z1));
                        const f32x2 l = __builtin_bit_cast(f32x2, z0), h = __builtin_bit_cast(f32x2, z1); acc[ai][bj][m][n] = (f32x4){l.x, l.y, h.x, h.y}; } }
    }
};
__device__ __forceinline__ size_t xb_off(int r, int c) { return ((size_t)(r >> 4) * (D / 32) + (c >> 5)) * 512 + (r & 15) * 32 + (c & 31); }
struct EpiResid {
    static constexpr bool PERM = true, ZEROES = false;
    bf16_t* XB; const u64* s1_in; bool has1; u64* ss_out; const float* gout; u64* s1_out;
    __device__ __forceinline__ void operator()(const f32x4 (&acc)[2][2][4][2], const pg8::Unit& u, int wr, int wc, int fr, int fq) {
        const int row0 = u.pm * 256 + wr * 64 + fr, col0 = u.pn * 256 + wc * 32 + 8 * fq;
        float psv[2][4];
#pragma unroll
        for (int ai = 0; ai < 2; ++ai)
#pragma unroll
            for (int m = 0; m < 4; ++m) psv[ai][m] = row_ps(s1_in, has1, row0 + ai * 128 + m * 16);
#define RESID_ROW(ai, m, XROW) do { const int r = row0 + ai * 128 + m * 16; const float ps = psv[ai][m]; float sA = 0.f, sB = 0.f; \
_Pragma("unroll") \
                for (int bj = 0; bj < 2; ++bj) { const u32x4 xw = XROW[bj]; \
                    f32x4 v0 = (f32x4){bflo(xw.x), bfhi(xw.x), bflo(xw.y), bfhi(xw.y)} * ps + acc[ai][bj][m][0], v1 = (f32x4){bflo(xw.z), bfhi(xw.z), bflo(xw.w), bfhi(xw.w)} * ps + acc[ai][bj][m][1]; \
                    if (gout) { sB += (v0[0] * v0[0] + v0[1] * v0[1]) + (v0[2] * v0[2] + v0[3] * v0[3]) + (v1[0] * v1[0] + v1[1] * v1[1]) + (v1[2] * v1[2] + v1[3] * v1[3]); \
                        v0 = v0 * *(const f32x4*)(gout + col0 + bj * 128); v1 = v1 * *(const f32x4*)(gout + col0 + bj * 128 + 4); } \
                    sA += (v0[0] * v0[0] + v0[1] * v0[1]) + (v0[2] * v0[2] + v0[3] * v0[3]) + (v1[0] * v1[0] + v1[1] * v1[1]) + (v1[2] * v1[2] + v1[3] * v1[3]); \
                    u32x4 w; w.x = cvt_pk_bf16(v0[0], v0[1]); w.y = cvt_pk_bf16(v0[2], v0[3]); w.z = cvt_pk_bf16(v1[0], v1[1]); w.w = cvt_pk_bf16(v1[2], v1[3]); \
                    *(u32x4*)(XB + xb_off(r, col0 + bj * 128)) = w; } \
                sA += __shfl_xor(sA, 16); sA += __shfl_xor(sA, 32); \
                if (gout) { sB += __shfl_xor(sB, 16); sB += __shfl_xor(sB, 32); } \
                if (fq == 0) { stat_add(ss_out, r, sA); if (gout) stat_add(s1_out, r, sB); } } while (0)
        u32x4 x0[4][2], x1[4][2];
#pragma unroll
        for (int m = 0; m < 4; ++m)
#pragma unroll
            for (int bj = 0; bj < 2; ++bj) x0[m][bj] = *(const u32x4*)(XB + xb_off(row0 + m * 16, col0 + bj * 128));
#pragma unroll
        for (int m = 0; m < 4; ++m) { RESID_ROW(0, m, x0[m]);
            if (m & 1) {
#pragma unroll
                for (int mm = m - 1; mm <= m; ++mm)
#pragma unroll
                    for (int bj = 0; bj < 2; ++bj) x1[mm][bj] = *(const u32x4*)(XB + xb_off(row0 + 128 + mm * 16, col0 + bj * 128)); } }
        asm volatile("" ::: "memory");
#pragma unroll
        for (int m = 0; m < 4; ++m) RESID_ROW(1, m, x1[m]);
#undef RESID_ROW
        { asm volatile("" ::: "memory"); }
    }
};
struct EpiQKV {
    static constexpr bool PERM = true, ZEROES = false;
    bf16_t* QKVb; const u64* ss; const float* qkg;
    __device__ __forceinline__ void operator()(const f32x4 (&acc)[2][2][4][2], const pg8::Unit& u, int wr, int wc, int fr, int fq) {
        float cfv[2][4];
        const int t = u.pn >> 3, row0 = u.pm * 256 + wr * 64 + fr, col0 = (u.pn & 7) * 256 + wc * 32 + 8 * fq;
        bf16_t* O = QKVb + (size_t)t * M * D;
        f32x4 ga = {1.f, 1.f, 1.f, 1.f}, gb = {1.f, 1.f, 1.f, 1.f};
#pragma unroll
        for (int ai = 0; ai < 2; ++ai)
#pragma unroll
            for (int m = 0; m < 4; ++m) cfv[ai][m] = row_cf(ss, ss, false, row0 + ai * 128 + m * 16);
        if (t < 2) { const float* gp = qkg + t * 64 + 8 * fq; ga = *(const f32x4*)gp; gb = *(const f32x4*)(gp + 4); if (t == 0) { ga = ga * QSCALE; gb = gb * QSCALE; } }
#pragma unroll
        for (int ai = 0; ai < 2; ++ai)
#pragma unroll
            for (int m = 0; m < 4; ++m) { const int r = row0 + ai * 128 + m * 16; const float cf = cfv[ai][m];
#pragma unroll
                for (int bj = 0; bj < 2; ++bj) { f32x4 v0 = acc[ai][bj][m][0] * cf, v1 = acc[ai][bj][m][1] * cf;
                    if (t < 2) { float q = (v0[0] * v0[0] + v0[1] * v0[1]) + (v0[2] * v0[2] + v0[3] * v0[3]) + (v1[0] * v1[0] + v1[1] * v1[1]) + (v1[2] * v1[2] + v1[3] * v1[3]);
                        q += __shfl_xor(q, 16); q += __shfl_xor(q, 32); const float hr = rsq(q * (1.0f / HD) + EPS); v0 = v0 * hr * ga; v1 = v1 * hr * gb; }
                    u32x4 w; w.x = cvt_pk_bf16(v0[0], v0[1]); w.y = cvt_pk_bf16(v0[2], v0[3]); w.z = cvt_pk_bf16(v1[0], v1[1]); w.w = cvt_pk_bf16(v1[2], v1[3]);
                    *(u32x4*)(O + (size_t)r * D + col0 + bj * 128) = w; } }
    }
};
struct EpiSguIn {
    static constexpr bool PERM = true, ZEROES = false;
    bf16_t* U; bf16_t* V; const u64* ss; u64* ssv;
    __device__ __forceinline__ void operator()(const f32x4 (&acc)[2][2][4][2], const pg8::Unit& u, int wr, int wc, int fr, int fq) {
        const int t = u.pn >> 4, row0 = u.pm * 256 + wr * 64 + fr, col0 = (u.pn & 15) * 256 + wc * 32 + 8 * fq;
        bf16_t* O = t ? V : U;
        float cfv[2][4];
#pragma unroll
        for (int ai = 0; ai < 2; ++ai)
#pragma unroll
            for (int m = 0; m < 4; ++m) cfv[ai][m] = row_cf(ss, ss, false, row0 + ai * 128 + m * 16);
#pragma unroll
        for (int ai = 0; ai < 2; ++ai)
#pragma unroll
            for (int m = 0; m < 4; ++m) { const int r = row0 + ai * 128 + m * 16; const float cf = cfv[ai][m]; float sv = 0.f;
#pragma unroll
                for (int bj = 0; bj < 2; ++bj) { const f32x4 v0 = acc[ai][bj][m][0] * cf, v1 = acc[ai][bj][m][1] * cf;
                    const f32x2 a = gelu_pk((f32x2){v0[0], v0[1]}), b = gelu_pk((f32x2){v0[2], v0[3]}), c = gelu_pk((f32x2){v1[0], v1[1]}), d = gelu_pk((f32x2){v1[2], v1[3]});
                    sv += (a.x * a.x + a.y * a.y) + (b.x * b.x + b.y * b.y) + (c.x * c.x + c.y * c.y) + (d.x * d.x + d.y * d.y);
                    u32x4 w; w.x = cvt_pk_bf16(a.x, a.y); w.y = cvt_pk_bf16(b.x, b.y); w.z = cvt_pk_bf16(c.x, c.y); w.w = cvt_pk_bf16(d.x, d.y);
                    *(u32x4*)(O + (size_t)r * DSGU + col0 + bj * 128) = w; }
                if (t) { sv += __shfl_xor(sv, 16); sv += __shfl_xor(sv, 32); if (fq == 0) stat_add(ssv, r, sv); } }
    }
};

constexpr size_t MiB = 1u << 20;
constexpr size_t WS_CTL = 0, CTL_ZERO_BYTES = 5 * MiB;
constexpr int CW_BAR = 1024;
constexpr size_t STAT_OFF = 65536;
constexpr int ST_F1 = 0, ST_S1 = 5, ST_MIX = 10, ST_F2 = 14, ST_V = 18, NSTAT = 19;
static_assert(STAT_OFF + (size_t)NSTAT * M * 8 <= CTL_ZERO_BYTES, "stats inside the memset region");
constexpr size_t WS_PAR = CTL_ZERO_BYTES;
constexpr int PAR_GOUT = 0, PAR_QG = 8192, PAR_KG = 8256  , PAR_RPB = 8320, PAR_VG = 67840, PAR_BS = 71936, PAR_WS = 73984, PAR_END = 336128;
static_assert(WS_PAR + (size_t)PAR_END * 4 <= 8 * MiB, "params region");
constexpr size_t WS_W = 8 * MiB;
constexpr size_t EL_FFN = (size_t)3 * D * DFF, EL_GU = (size_t)2 * D * DFF;
constexpr size_t EL_NA0 = 8 * EL_FFN, EL_NA = (size_t)4 * D * D, EL_QKV = (size_t)3 * D * D;
constexpr size_t EL_SGU = EL_NA0 + 2 * EL_NA, EL_SIN = (size_t)D * SGU_IN, EL_SOUT = (size_t)DSGU * D, EL_WS = (size_t)SGG * CHUNK * CHUNK;
constexpr size_t EL_POOL = EL_SGU + EL_SIN + EL_SOUT + EL_WS, EL_END = EL_POOL + (size_t)4 * PGD * PGD;
constexpr size_t WS_XB = WS_W + ((EL_END * 2 + MiB - 1) / MiB) * MiB;
constexpr size_t WS_BIG = WS_XB + (size_t)M * D * 2;
constexpr size_t WS_END = WS_BIG + 512 * MiB;

constexpr int RING_BYTES = 131072, MISC_OFF = RING_BYTES + 320, LDS_BYTES = 147456;

#define XB_TMO      128
#define XB_XCNT(j)  (256  + 64 * (j))
#define XB_XSUB(j)  (1280 + 64 * (j))
#define XB_XGEN(j)  (2304 + 64 * (j))
#define XB_TOP      3328
#define XB_TOPGEN   3392
#define XCD_BAR_WORDS 3456
#define XB_SPIN_CAP (1u << 18)
__device__ __forceinline__ unsigned xb_ld(unsigned* p)              { return __hip_atomic_load(p, __ATOMIC_RELAXED, __HIP_MEMORY_SCOPE_AGENT); }
__device__ __forceinline__ unsigned xb_add(unsigned* p, unsigned v) { return __hip_atomic_fetch_add(p, v, __ATOMIC_RELAXED, __HIP_MEMORY_SCOPE_AGENT); }
__device__ __forceinline__ unsigned xb_xcc_id() { return (unsigned)__builtin_amdgcn_s_getreg((3 << 11) | 20) & 0xFu; }
#define XB_SPIN(cond, bar) do { unsigned _sp = 0; while (cond) { __builtin_amdgcn_s_sleep(1); \
    if ((++_sp & 255u) == 0u) { if (xb_ld(&(bar)[XB_TMO])) break; if (_sp > XB_SPIN_CAP) { atomicAdd(&(bar)[XB_TMO], 1u); break; } } } } while (0)
struct XcdBarrier { unsigned* bar; unsigned x; volatile LAS unsigned* st; };
__device__ __forceinline__ XcdBarrier xcd_barrier_post(unsigned* bar, volatile LAS unsigned* st) {
    XcdBarrier b; b.bar = bar; b.x = xb_xcc_id(); b.st = st;
    if (threadIdx.x == 0) (void)xb_add(&bar[XB_XCNT(b.x)], 1u);
    return b;
}
__device__ __forceinline__ void xcd_barrier_complete(unsigned* bar, unsigned x, unsigned& nloc, unsigned& nx) {
    const unsigned G = gridDim.x * gridDim.y * gridDim.z;
    unsigned sum, cnt, mine, sp = 0u;
    for (;;) {
        sum = 0u; cnt = 0u; mine = 0u;
#pragma unroll
        for (unsigned j = 0; j < 16; ++j) { const unsigned c = xb_ld(&bar[XB_XCNT(j)]); sum += c; cnt += (c > 0u) ? 1u : 0u; mine = (j == x) ? c : mine; }
        if (sum == G) break;
        __builtin_amdgcn_s_sleep(1);
        if ((++sp & 255u) == 0u) { if (xb_ld(&bar[XB_TMO])) break; if (sp > XB_SPIN_CAP) { atomicAdd(&bar[XB_TMO], 1u); break; } }
    }
    nloc = mine > 0u ? mine : 1u; nx = cnt > 0u ? cnt : 1u;
}
__device__ __forceinline__ void xcd_barrier(const XcdBarrier& b) {
    asm volatile("s_waitcnt vmcnt(0)" ::: "memory");
    __syncthreads();
    if (threadIdx.x == 0) {
        unsigned* bar = b.bar;
        __builtin_amdgcn_s_waitcnt(0);
        unsigned nloc = b.st[0], nx = b.st[1];
        if (nloc == 0u) { xcd_barrier_complete(bar, b.x, nloc, nx); b.st[0] = nloc; b.st[1] = nx; }
        const unsigned old = xb_add(&bar[XB_XSUB(b.x)], 1u);
        const unsigned gen = old / nloc;
        if (old + 1u == (gen + 1u) * nloc) {
            __builtin_amdgcn_fence(__ATOMIC_RELEASE, "agent");
            asm volatile("s_waitcnt vmcnt(0)" ::: "memory");
            const unsigned og = xb_add(&bar[XB_TOP], 1u);
            const unsigned tg = og / nx;
            if (og + 1u == (tg + 1u) * nx) xb_add(&bar[XB_TOPGEN], 1u);
            else XB_SPIN(xb_ld(&bar[XB_TOPGEN]) == tg, bar);
            __builtin_amdgcn_fence(__ATOMIC_ACQUIRE, "agent");
            xb_add(&bar[XB_XGEN(b.x)], 1u);
            asm volatile("s_waitcnt vmcnt(0)" ::: "memory");
        } else {
            XB_SPIN(xb_ld(&bar[XB_XGEN(b.x)]) == gen, bar);
            __builtin_amdgcn_fence(__ATOMIC_ACQUIRE, "agent");
            asm volatile("s_waitcnt vmcnt(0)" ::: "memory");
        }
    }
    __syncthreads();
}

struct TrDesc { const float* W; bf16_t* WT; const float* gain; const float* nscale; float scale; int N, ldt, row_off, ilv, k0, n0; };
__device__ __forceinline__ void tr_set(TrDesc& d, const float* W, int K, int N, bf16_t* WT, int ldt, int row_off, int ilv, const float* gain, const float* nscale, float scale, int item) {
    const int nblk = N / 32, kb = item / nblk, nb = item % nblk; (void)K;
    d.W = W; d.WT = WT; d.gain = gain; d.nscale = nscale; d.scale = scale; d.N = N; d.ldt = ldt; d.row_off = row_off; d.ilv = ilv; d.k0 = 64 * kb; d.n0 = 32 * nb;
}
__device__ __forceinline__ void tr_load(const TrDesc& d, float (&v)[32], int lane) {
#pragma unroll
    for (int i = 0; i < 32; ++i) v[i] = d.W[(size_t)(d.k0 + 2 * i + (lane >> 5)) * d.N + d.n0 + (lane & 31)];
}
__device__ __forceinline__ void tr_store(const TrDesc& d, const float (&v)[32], LAS float* scr, int lane) {
    const float ns = (d.nscale ? d.nscale[d.n0 + (lane & 31)] : 1.0f) * d.scale;
#pragma unroll
    for (int i = 0; i < 32; ++i) { const int kk = 2 * i + (lane >> 5); const float gk = d.gain ? d.gain[d.k0 + kk] : 1.0f; scr[kk * 33 + (lane & 31)] = v[i] * (gk * ns); }
    asm volatile("s_waitcnt lgkmcnt(0)" ::: "memory");
    const int c = lane & 7;
    const int rbase = d.ilv < 0 ? d.row_off + d.n0 : (d.n0 >> 7) * 256 + d.ilv * 128 + (d.n0 & 127);
#pragma unroll
    for (int j = 0; j < 4; ++j) { const int n = (lane >> 3) + 8 * j; const LAS float* sp = scr + (8 * c) * 33 + n;
        u32x4 o; o.x = cvt_pk_bf16(sp[0 * 33], sp[1 * 33]); o.y = cvt_pk_bf16(sp[2 * 33], sp[3 * 33]); o.z = cvt_pk_bf16(sp[4 * 33], sp[5 * 33]); o.w = cvt_pk_bf16(sp[6 * 33], sp[7 * 33]);
        const int R = rbase + 16 * ((n >> 2) & 1) + 4 * (n >> 3) + (n & 3);
        *(u32x4*)(d.WT + ((size_t)(R >> 4) * (d.ldt >> 5) + (d.k0 >> 5) + (c >> 2)) * 512 + (R & 15) * 32 + 8 * (c & 3)) = o; }
    asm volatile("s_waitcnt lgkmcnt(0)" ::: "memory");
}

struct Args { const float* in[23]; float* out; unsigned char* ws; int ph_lo, ph_hi; };

__device__ __forceinline__ float wave_sum(float v) {
#pragma unroll
    for (int o = 1; o < 64; o <<= 1) v += __shfl_xor(v, o);
    return v;
}

__global__ void __launch_bounds__(512, 2) mega_fwd(Args a) {
    extern __shared__ __attribute__((aligned(16))) unsigned char lds_raw[];
    LAS unsigned char* lds = (LAS unsigned char*)lds_raw;
    volatile LAS unsigned* MISC = (volatile LAS unsigned*)(lds + MISC_OFF);
    const int tid = threadIdx.x, lane = tid & 63, wave = __builtin_amdgcn_readfirstlane(tid >> 6);
    const int G = gridDim.x, bx = blockIdx.x;
    const int vcu = (G % 8 == 0) ? (bx % 8) * (G / 8) + bx / 8 : bx;
    const int gw = vcu * 8 + wave, NGW = G * 8;
    unsigned char* ws = a.ws;
    unsigned* ctl = (unsigned*)(ws + WS_CTL);
    u64* stat = (u64*)(ws + STAT_OFF);
    float* par = (float*)(ws + WS_PAR);
    bf16_t* Wb = (bf16_t*)(ws + WS_W);
    bf16_t* XB = (bf16_t*)(ws + WS_XB);
    bf16_t* BIG = (bf16_t*)(ws + WS_BIG);
    float* X = a.out;
    for (int u = tid; u < (LDS_BYTES - RING_BYTES) / 4; u += 512) ((LAS unsigned*)(lds + RING_BYTES))[u] = 0u;
    __syncthreads();
    XcdBarrier bar = xcd_barrier_post(ctl + CW_BAR, MISC + 8);
    const int lo = a.ph_lo, hi = a.ph_hi;
    int pc = 0;
#ifndef PHMASK
#define PHMASK 0xffff
#endif
#define EN(k) (((PHMASK) >> (k)) & 1)
#define PH_ON (pc >= lo && pc < hi)
#define PH_END do { if (pc + 1 < hi) xcd_barrier(bar); } while (0)
#define STAT(i) (stat + (size_t)(i) * M)

    if (PH_ON && EN(0)) {
        LAS float* scr = (LAS float*)(lds + wave * 16384);
        constexpr int IT_FFN = 5632, N_FFN = 24 * IT_FFN, IT_QKV = 32 * 192, IT_WO = 32 * 64, IT_SIN = 32 * 256, IT_SOUT = 64 * 64, IT_POOL = 8 * 16;
        constexpr int N_ITEMS = N_FFN + 2 * (IT_QKV + IT_WO) + IT_SIN + IT_SOUT + 4 * IT_POOL;
#define TR_DECODE(IT, DD) do { int r = (IT); \
            if (r < N_FFN) { const int mat = r / IT_FFN, f = mat / 3, k = mat % 3, layer_ = f >> 1, which_ = f & 1; r -= mat * IT_FFN; bf16_t* base = Wb + (size_t)f * EL_FFN; \
                if (k < 2) tr_set(DD, a.in[(which_ ? 7 : 2) + k] + (size_t)layer_ * D * DFF, D, DFF, base, D, 0, k, a.in[which_ ? 6 : 1] + (size_t)layer_ * D, nullptr, 1.0f, r); \
                else tr_set(DD, a.in[which_ ? 9 : 4] + (size_t)layer_ * DFF * D, DFF, D, base + EL_GU, DFF, 0, -1, nullptr, nullptr, 0.5f, r); break; } \
            r -= N_FFN; \
            if (r < 2 * (IT_QKV + IT_WO)) { const int j = r / (IT_QKV + IT_WO); r -= j * (IT_QKV + IT_WO); \
                if (r < IT_QKV) tr_set(DD, a.in[11] + (size_t)j * D * NQKV, D, NQKV, Wb + EL_NA0 + j * EL_NA, D, 0, -1, a.in[5] + (size_t)(3 * j) * D, nullptr, 1.0f, r); \
                else tr_set(DD, a.in[15] + (size_t)j * D * D, D, D, Wb + EL_NA0 + j * EL_NA + EL_QKV, D, 0, -1, nullptr, nullptr, 1.0f, r - IT_QKV); break; } \
            r -= 2 * (IT_QKV + IT_WO); \
            if (r < IT_SIN) { tr_set(DD, a.in[16], D, SGU_IN, Wb + EL_SGU, D, 0, -1, a.in[5] + (size_t)1 * D, nullptr, 1.0f, r); break; } r -= IT_SIN; \
            if (r < IT_SOUT) { tr_set(DD, a.in[20], DSGU, D, Wb + EL_SGU + EL_SIN, DSGU, 0, -1, nullptr, nullptr, 1.0f, r); break; } r -= IT_SOUT; \
            { const int gp = r / IT_POOL; r -= gp * IT_POOL; \
              tr_set(DD, a.in[21] + (size_t)gp * PGD * PGD, PGD, PGD, Wb + EL_POOL, PGD, gp * PGD, -1, a.in[5] + (size_t)2 * D + gp * PGD, a.in[22] + gp * PGD, 1.0f, r); } } while (0)
        { TrDesc d0, d1; float v0[32], v1[32]; int it = gw; bool h0 = it < N_ITEMS;
          if (h0) { TR_DECODE(it, d0); tr_load(d0, v0, lane); }
          while (h0) {
              const int it1 = it + NGW; const bool h1 = it1 < N_ITEMS;
              if (h1) { TR_DECODE(it1, d1); tr_load(d1, v1, lane); }
              tr_store(d0, v0, scr, lane);
              if (!h1) break;
              it = it1 + NGW; h0 = it < N_ITEMS;
              if (h0) { TR_DECODE(it, d0); tr_load(d0, v0, lane); }
              tr_store(d1, v1, scr, lane);
          } }
#undef TR_DECODE
        { const float* wsrc = a.in[18]; bf16_t* wdst = Wb + EL_SGU + EL_SIN + EL_SOUT;
          for (int i = (gw * 64 + lane) * 2; i < (int)EL_WS; i += NGW * 128) *(unsigned*)(wdst + i) = cvt_pk_bf16(wsrc[i], wsrc[i + 1]); }
        { const int gt = gw * 64 + lane, NT = NGW * 64;
          for (int i = gt; i < 8192; i += NT) par[PAR_GOUT + i] = a.in[10][i];
          for (int i = gt; i < 64; i += NT) { par[PAR_QG + i] = a.in[12][i]; par[PAR_KG + i] = a.in[13][i]; }
          for (int i = gt; i < 59520; i += NT) par[PAR_RPB + i] = a.in[14][i] * LOG2E;
          for (int i = gt; i < 4096; i += NT) par[PAR_VG + i] = a.in[17][i];
          for (int i = gt; i < 2048; i += NT) par[PAR_BS + i] = a.in[19][i];
          for (int i = gt; i < 262144; i += NT) par[PAR_WS + i] = a.in[18][i]; }
        for (int m2 = gw; m2 < M / 2; m2 += NGW) {
            const int m = 2 * m2 + (lane >> 5), hl = lane & 31;
            const f32x4* xr = (const f32x4*)(a.in[0] + (size_t)m * D) + 2 * hl; bf16_t* bo = XB + xb_off(m, 8 * hl);
            float s = 0.f;
#pragma unroll
            for (int j = 0; j < 8; ++j) { const f32x4 v0 = xr[64 * j], v1 = xr[64 * j + 1];
                s += (v0[0] * v0[0] + v0[1] * v0[1]) + (v0[2] * v0[2] + v0[3] * v0[3]) + (v1[0] * v1[0] + v1[1] * v1[1]) + (v1[2] * v1[2] + v1[3] * v1[3]);
                u32x4 w; w.x = cvt_pk_bf16(v0[0], v0[1]); w.y = cvt_pk_bf16(v0[2], v0[3]); w.z = cvt_pk_bf16(v1[0], v1[1]); w.w = cvt_pk_bf16(v1[2], v1[3]); *(u32x4*)(bo + (size_t)j * 8 * 512) = w; }
#pragma unroll
            for (int o = 1; o < 32; o <<= 1) s += __shfl_xor(s, o);
            if (hl == 0) STAT(ST_F1 + 0)[m] = stat_fix(s);
        }
        PH_END;
    }
    ++pc;

    for (int step = 0; step < 2 * DEPTH; ++step) {
        const int layer = step >> 1, which = step & 1, kind = layer % 3, jm = layer / 3;
        if (which == 1) {
            if (kind == 0) {
                bf16_t* Q = BIG; bf16_t* Kb = BIG + (size_t)M * D; bf16_t* Vb = BIG + (size_t)2 * M * D; bf16_t* Ob = BIG + (size_t)3 * M * D;
                if (PH_ON && EN(6)) {

                    EpiQKV E{Q, STAT(ST_MIX + layer), par + PAR_QG + jm * HD};
                    pg8::gemm_phase<EpiQKV, pg8::Shape<NQKV, D, D, D, 0, 0, 8, 1>>(lds, XB, Wb + EL_NA0 + jm * EL_NA, G, bx, E);
                    PH_END;
                }
                ++pc;
                if (PH_ON && EN(2)) {
                    constexpr int VT_STRIDE = 1928, VT_OFF = 15 * 64 * 64, BI_OFF = VT_OFF + 32 * VT_STRIDE;
                    static_assert(BI_OFF + 529 * 4 <= RING_BYTES, "attention LDS");
                    int tq_ = threadIdx.x; asm volatile("" : "+v"(tq_));
                    const int tq = tq_, l = tq & 63, q = l & 15, g = l >> 4;
                    const float* rpbj = par + PAR_RPB + jm * NHEAD * 465;
                    for (int un = vcu; un < 2 * NHEAD * 32; un += G) {
                        const int h = un & 63, rb = (un >> 6) & 31, b = un >> 11;
                        const int R0 = rb * 8, KR0 = min(max(R0 - 4, 0), GROWS - 15);
                        const int r = R0 + wave, rs = min(max(r - 4, 0), GROWS - 8), krb = rs - KR0, drb = rs - r + 7;
                        bf16x8 qf[4];
#pragma unroll
                        for (int jb = 0; jb < 4; ++jb) qf[jb] = *(const bf16x8*)(Q + ((size_t)(b << 14) + r * 64 + 16 * jb + q) * D + h * 32 + 8 * g);
                        __syncthreads();
#pragma unroll
                        for (int e = 0; e < 4; ++e) { const int idx = tq + 512 * e;
                            if (idx < 15 * 32 * 4) { const int tok = (idx >> 2) * 2, ch = idx & 3; const size_t go = ((size_t)(b << 14) + KR0 * 64 + tok) * D + h * 32 + ch * 8;
                                const u32x4 ka = *(const u32x4*)(Kb + go), kb2 = *(const u32x4*)(Kb + go + D), va = *(const u32x4*)(Vb + go), vb = *(const u32x4*)(Vb + go + D);
                                *(LAS u32x4*)(lds + tok * 64 + ((ch ^ ((tok >> 2) & 3)) * 16)) = ka;
                                *(LAS u32x4*)(lds + (tok + 1) * 64 + ((ch ^ (((tok + 1) >> 2) & 3)) * 16)) = kb2;
                                LAS unsigned* vt = (LAS unsigned*)(lds + VT_OFF + (ch * 8) * VT_STRIDE + tok * 2); constexpr int VS = VT_STRIDE / 4;
                                vt[0 * VS] = (va.x & 0xffffu) | (vb.x << 16); vt[1 * VS] = (va.x >> 16) | (vb.x & 0xffff0000u); vt[2 * VS] = (va.y & 0xffffu) | (vb.y << 16); vt[3 * VS] = (va.y >> 16) | (vb.y & 0xffff0000u);
                                vt[4 * VS] = (va.z & 0xffffu) | (vb.z << 16); vt[5 * VS] = (va.z >> 16) | (vb.z & 0xffff0000u); vt[6 * VS] = (va.w & 0xffffu) | (vb.w << 16); vt[7 * VS] = (va.w >> 16) | (vb.w & 0xffff0000u); } }
                        if (tq < 529) ((LAS float*)(lds + BI_OFF))[tq] = (tq >= 32 && tq < 497) ? rpbj[h * 465 + tq - 32] : 0.f;
                        asm volatile("s_waitcnt vmcnt(0) lgkmcnt(0)" ::: "memory");
                        __syncthreads();
#pragma unroll 1
                        for (int jb = 0; jb < 4; ++jb) {
                            const int c = 16 * jb + q, cs = min(max(c - 8, 0), GRID_W - 16), kc0 = min(max(16 * jb - 8, 0), 32);
                            const int swz = (((kc0 >> 2) + (q >> 2)) & 3);
                            const bf16x8 qv = jb == 0 ? qf[0] : (jb == 1 ? qf[1] : (jb == 2 ? qf[2] : qf[3]));
                            f32x4 s[8][2];
#pragma unroll
                            for (int i = 0; i < 8; ++i)
#pragma unroll
                                for (int cb = 0; cb < 2; ++cb) { const int tokk = (krb + i) * 64 + kc0 + 16 * cb + q;
                                    const bf16x8 kf = *(const LAS bf16x8*)(lds + tokk * 64 + ((g ^ swz) * 16));
                                    s[i][cb] = __builtin_amdgcn_mfma_f32_16x16x32_bf16(kf, qv, (f32x4){0.f, 0.f, 0.f, 0.f}, 0, 0, 0); }
                            const int t = cs - kc0; bool sl[4]; const LAS float* blr[4];
                            const LAS float* bl = (const LAS float*)(lds + BI_OFF) + (32 + drb * 31 + kc0 + 4 * g - c + 15);
#pragma unroll
                            for (int rg = 0; rg < 4; ++rg) { sl[rg] = (4 * g + rg) >= t; blr[rg] = bl + (sl[rg] ? rg : 16 + rg); }
                            const unsigned m01 = (sl[0] ? 0xffffu : 0u) | (sl[1] ? 0xffff0000u : 0u), m23 = (sl[2] ? 0xffffu : 0u) | (sl[3] ? 0xffff0000u : 0u);
                            float mx = -1e30f;
#pragma unroll
                            for (int i = 0; i < 8; ++i)
#pragma unroll
                                for (int rg = 0; rg < 4; ++rg) { const float v = (sl[rg] ? s[i][0][rg] : s[i][1][rg]) + blr[rg][31 * i]; s[i][0][rg] = v; mx = fmaxf(mx, v); }
                            mx = fmaxf(mx, __shfl_xor(mx, 16)); mx = fmaxf(mx, __shfl_xor(mx, 32));
                            float sum = 0.f; bf16x8 pb[8];
#pragma unroll
                            for (int i = 0; i < 8; ++i) { float p[4];
#pragma unroll
                                for (int rg = 0; rg < 4; ++rg) { p[rg] = __builtin_amdgcn_exp2f(s[i][0][rg] - mx); sum += p[rg]; }
                                const unsigned p01 = cvt_pk_bf16(p[0], p[1]), p23 = cvt_pk_bf16(p[2], p[3]);
                                u32x4 w; w.x = p01 & m01; w.y = p23 & m23; w.z = p01 & ~m01; w.w = p23 & ~m23;
                                pb[i] = __builtin_bit_cast(bf16x8, w); }
                            sum += __shfl_xor(sum, 16); sum += __shfl_xor(sum, 32);
                            f32x4 o0 = {0.f, 0.f, 0.f, 0.f}, o1 = {0.f, 0.f, 0.f, 0.f};
#pragma unroll
                            for (int i = 0; i < 8; ++i) { const LAS unsigned char* vb = lds + VT_OFF + q * VT_STRIDE + ((krb + i) * 64 + kc0 + 4 * g) * 2;
                                const u32x2 a0 = *(const LAS u32x2*)(vb), a1 = *(const LAS u32x2*)(vb + 32), c0 = *(const LAS u32x2*)(vb + 16 * VT_STRIDE), c1 = *(const LAS u32x2*)(vb + 16 * VT_STRIDE + 32);
                                const bf16x8 va = __builtin_bit_cast(bf16x8, (u32x4){a0.x, a0.y, a1.x, a1.y}), vc = __builtin_bit_cast(bf16x8, (u32x4){c0.x, c0.y, c1.x, c1.y});
                                o0 = __builtin_amdgcn_mfma_f32_16x16x32_bf16(va, pb[i], o0, 0, 0, 0); o1 = __builtin_amdgcn_mfma_f32_16x16x32_bf16(vc, pb[i], o1, 0, 0, 0); }
                            const float inv = 1.0f / sum; bf16_t* op = Ob + ((size_t)(b << 14) + r * 64 + c) * D + h * 32 + 4 * g;
                            u32x2 w0v, w1v; w0v.x = cvt_pk_bf16(o0[0] * inv, o0[1] * inv); w0v.y = cvt_pk_bf16(o0[2] * inv, o0[3] * inv); w1v.x = cvt_pk_bf16(o1[0] * inv, o1[1] * inv); w1v.y = cvt_pk_bf16(o1[2] * inv, o1[3] * inv);
                            *(u32x2*)op = w0v; *(u32x2*)(op + 16) = w1v;
                        }
                    }
                    PH_END;
                }
                ++pc;
                if (PH_ON && EN(7)) {

                    EpiResid E{XB, STAT(ST_F2 + layer), false, STAT(ST_F2 + layer), nullptr, nullptr};
                    pg8::gemm_phase<EpiResid, pg8::Shape<D, D, D, D, 0, 0, 4>>(lds, Ob, Wb + EL_NA0 + jm * EL_NA + EL_QKV, G, bx, E);
                    PH_END;
                }
                ++pc;
            } else if (kind == 1) {
                bf16_t* U = BIG; bf16_t* V = BIG + (size_t)M * DSGU;
                if (PH_ON && EN(8)) {

                    EpiSguIn E{U, V, STAT(ST_MIX + layer), STAT(ST_V)};
                    pg8::gemm_phase<EpiSguIn, pg8::Shape<SGU_IN, D, D, D, 0, 0, 8, 1>>(lds, XB, Wb + EL_SGU, G, bx, E);
                    PH_END;
                }
                ++pc;

                if (PH_ON && EN(3)) {
                    constexpr int LSTR = 272, VN_OFF = 128 * LSTR;
                    static_assert(VN_OFF + 256 * LSTR <= RING_BYTES, "SGU LDS");
                    int tq_ = threadIdx.x; asm volatile("" : "+v"(tq_));
                    const int tq = tq_, l = tq & 63, q = l & 15, g = l >> 4;
                    const u64* ssv = STAT(ST_V);
                    const int gq = bx & 15;
                    if ((G & 15) == 0) {
                        const bf16_t* wsrc = Wb + EL_SGU + EL_SIN + EL_SOUT + (size_t)gq * CHUNK * CHUNK;
#pragma unroll
                        for (int e = 0; e < 4; ++e) { const int id = tq + 512 * e, i = id >> 4, cj = id & 15; *(LAS u32x4*)(lds + i * LSTR + cj * 16) = *(const u32x4*)(wsrc + i * CHUNK + cj * 8); }
                    }
                    for (int un = bx; un < (M / CHUNK) * SGG; un += G) {
                        const int n = un >> 4;
                        __syncthreads();
                        if ((G & 15) != 0) {
                            const bf16_t* wsrc = Wb + EL_SGU + EL_SIN + EL_SOUT + (size_t)(un & 15) * CHUNK * CHUNK;
#pragma unroll
                            for (int e = 0; e < 4; ++e) { const int id = tq + 512 * e, i = id >> 4, cj = id & 15; *(LAS u32x4*)(lds + i * LSTR + cj * 16) = *(const u32x4*)(wsrc + i * CHUNK + cj * 8); }
                        }
                        const int gu = un & 15;
#pragma unroll
                        for (int e = 0; e < 4; ++e) { const int id = tq + 512 * e, j = (id & 63) * 2, cc = id >> 6; const int tok = n * CHUNK + j;
                            const u32x4 va = *(const u32x4*)(V + (size_t)tok * DSGU + gu * SGD + cc * 8), vb = *(const u32x4*)(V + (size_t)(tok + 1) * DSGU + gu * SGD + cc * 8);
                            const float ra = rsq(stat_get(ssv, tok) * (1.0f / DSGU) + EPS), rb = rsq(stat_get(ssv, tok + 1) * (1.0f / DSGU) + EPS);
                            LAS unsigned* vt = (LAS unsigned*)(lds + VN_OFF + (cc * 8) * LSTR + j * 2); constexpr int VS = LSTR / 4;
#define B2_PAIR(dd, W) do { vt[(2 * dd) * VS] = cvt_pk_bf16(bflo(va.W) * ra, bflo(vb.W) * rb); vt[(2 * dd + 1) * VS] = cvt_pk_bf16(bfhi(va.W) * ra, bfhi(vb.W) * rb); } while (0)
                            B2_PAIR(0, x); B2_PAIR(1, y); B2_PAIR(2, z); B2_PAIR(3, w);
#undef B2_PAIR
                        }
                        asm volatile("s_waitcnt vmcnt(0) lgkmcnt(0)" ::: "memory");
                        __syncthreads();
                        f32x4 acc[2][8];
#pragma unroll
                        for (int ct = 0; ct < 2; ++ct)
#pragma unroll
                            for (int it = 0; it < 8; ++it) acc[ct][it] = (f32x4){0.f, 0.f, 0.f, 0.f};
#pragma unroll
                        for (int ks = 0; ks < 4; ++ks) {
                            const bf16x8 a0 = *(const LAS bf16x8*)(lds + VN_OFF + (32 * wave + q) * LSTR + (ks * 32 + 8 * g) * 2), a1 = *(const LAS bf16x8*)(lds + VN_OFF + (32 * wave + 16 + q) * LSTR + (ks * 32 + 8 * g) * 2);
#pragma unroll
                            for (int it = 0; it < 8; ++it) { const bf16x8 wf = *(const LAS bf16x8*)(lds + (16 * it + q) * LSTR + (ks * 32 + 8 * g) * 2);
                                acc[0][it] = __builtin_amdgcn_mfma_f32_16x16x32_bf16(a0, wf, acc[0][it], 0, 0, 0); acc[1][it] = __builtin_amdgcn_mfma_f32_16x16x32_bf16(a1, wf, acc[1][it], 0, 0, 0); }
                        }
#pragma unroll
                        for (int ct = 0; ct < 2; ++ct) { const int chb = gu * SGD + 32 * wave + 16 * ct + 4 * g; const f32x4 gn = *(const f32x4*)(par + PAR_VG + chb);
#pragma unroll
                            for (int it = 0; it < 8; ++it) { const int i = 16 * it + q; const float bs = par[PAR_BS + gu * CHUNK + i];
                                bf16_t* up = U + (size_t)(n * CHUNK + i) * DSGU + chb; const u32x2 uw = *(const u32x2*)up; const f32x4 a = acc[ct][it];
                                u32x2 w; w.x = cvt_pk_bf16(bflo(uw.x) * (gn[0] * a[0] + bs), bfhi(uw.x) * (gn[1] * a[1] + bs)); w.y = cvt_pk_bf16(bflo(uw.y) * (gn[2] * a[2] + bs), bfhi(uw.y) * (gn[3] * a[3] + bs));
                                *(u32x2*)up = w; } }
                    }
                    PH_END;
                }
                ++pc;
                if (PH_ON && EN(9)) {

                    EpiResid E{XB, STAT(ST_F2 + layer), false, STAT(ST_F2 + layer), nullptr, nullptr};
                    pg8::gemm_phase<EpiResid, pg8::Shape<D, DSGU, DSGU, DSGU, 0, 0, 4>>(lds, U, Wb + EL_SGU + EL_SIN, G, bx, E);
                    PH_END;
                }
                ++pc;
            } else {
                bf16_t* P = BIG;
                if (PH_ON && EN(4)) {
                    const u64* ssm = STAT(ST_MIX + layer);
                    const int gi = lane >> 4, hw = 1 << gi;
#define POOL_ROW(ROWT, WGT, OP) do { const int sx_ = (ROWT); const bool in_ = (sx_ >= 0) && (sx_ < SEQ) && (WGT); const int row_ = (b << 14) + min(max(sx_, 0), SEQ - 1); \
        const float rs_ = in_ ? rsq(stat_get(ssm, row_) * (1.0f / D) + EPS) : 0.f; const u32x4* xp_ = (const u32x4*)(XB + xb_off(row_, lane * 32)); \
        _Pragma("unroll") for (int e = 0; e < 4; ++e) { const u32x4 w_ = xp_[e]; \
            sum[8 * e + 0] OP bflo(w_.x) * rs_; sum[8 * e + 1] OP bfhi(w_.x) * rs_; sum[8 * e + 2] OP bflo(w_.y) * rs_; sum[8 * e + 3] OP bfhi(w_.y) * rs_; \
            sum[8 * e + 4] OP bflo(w_.z) * rs_; sum[8 * e + 5] OP bfhi(w_.z) * rs_; sum[8 * e + 6] OP bflo(w_.w) * rs_; sum[8 * e + 7] OP bfhi(w_.w) * rs_; } } while (0)
                    for (int run = gw; run < M / 16; run += NGW) {
                        const int t0 = run * 16, b = t0 >> 14, tt0 = t0 & 16383;
                        float sum[32];
#pragma unroll
                        for (int e = 0; e < 32; ++e) sum[e] = 0.f;
#pragma unroll 4
                        for (int off = -8; off < 8; ++off) POOL_ROW(tt0 + off, (off >= -hw) && (off < hw), +=);
#pragma unroll 2
                        for (int k = 0; k < 16; ++k) {
                            const int tt = tt0 + k, t = t0 + k;
                            const float ic = 1.0f / (float)(min(tt + hw, SEQ) - max(tt - hw, 0)), rst = rsq(stat_get(ssm, t) * (1.0f / D) + EPS);
                            const u32x4* xs = (const u32x4*)(XB + xb_off(t, lane * 32)); u32x4* pp = (u32x4*)(P + (size_t)t * D + lane * 32);
#pragma unroll
                            for (int e = 0; e < 4; ++e) { const u32x4 x = xs[e]; u32x4 w;
                                w.x = cvt_pk_bf16(sum[8 * e + 0] * ic - bflo(x.x) * rst, sum[8 * e + 1] * ic - bfhi(x.x) * rst); w.y = cvt_pk_bf16(sum[8 * e + 2] * ic - bflo(x.y) * rst, sum[8 * e + 3] * ic - bfhi(x.y) * rst);
                                w.z = cvt_pk_bf16(sum[8 * e + 4] * ic - bflo(x.z) * rst, sum[8 * e + 5] * ic - bfhi(x.z) * rst); w.w = cvt_pk_bf16(sum[8 * e + 6] * ic - bflo(x.w) * rst, sum[8 * e + 7] * ic - bfhi(x.w) * rst); pp[e] = w; }
                            POOL_ROW(tt + hw, true, +=);
                            POOL_ROW(tt - hw, true, -=);
                        }
                    }
#undef POOL_ROW
                    PH_END;
                }
                ++pc;
                if (PH_ON && EN(10)) {

                    EpiResid E{XB, STAT(ST_F2 + layer), false, STAT(ST_F2 + layer), nullptr, nullptr};
                    pg8::gemm_phase<EpiResid, pg8::Shape<D, PGD, D, PGD, 2, PGD * 2>>(lds, P, Wb + EL_POOL, G, bx, E);
                    PH_END;
                }
                ++pc;
            }
        }
        bf16_t* H = BIG;
        const bf16_t* Wf = Wb + (size_t)step * EL_FFN;
        if (PH_ON && EN(11)) {

            EpiSwiGLU E{H, which ? STAT(ST_F2 + layer) : STAT(ST_F1 + layer), STAT(ST_S1 + layer), (which == 0 && layer > 0), -1, {}};
            pg8::gemm_phase<EpiSwiGLU, pg8::Shape<2 * DFF, D, D, D, 0, 0, 8, 1>>(lds, XB, Wf, G, bx, E);
            PH_END;
        }
        ++pc;

        if (PH_ON && EN(12)) {

            EpiResid E{XB, STAT(ST_S1 + layer), (which == 0 && layer > 0), which ? STAT(ST_F1 + layer + 1) : STAT(ST_MIX + layer),
                       which ? par + PAR_GOUT + layer * D : nullptr, which ? STAT(ST_S1 + layer + 1) : nullptr};
            pg8::gemm_phase<EpiResid, pg8::Shape<D, DFF, DFF, DFF, 0, 0, 4, 1>>(lds, H, Wf + EL_GU, G, bx, E);
            PH_END;
        }
        ++pc;
    }
    if (PH_ON && EN(5)) {
        const u64* s1 = STAT(ST_S1 + DEPTH);
        for (int m2 = gw; m2 < M / 2; m2 += NGW) { const int m = 2 * m2 + (lane >> 5), hl = lane & 31;
            const float ps = rsq(stat_get(s1, m) * (1.0f / D) + EPS); f32x4* xo = (f32x4*)(X + (size_t)m * D) + 2 * hl; const bf16_t* xb = XB + xb_off(m, 8 * hl);
#pragma unroll
            for (int j = 0; j < 8; ++j) { const u32x4 w = *(const u32x4*)(xb + (size_t)j * 8 * 512);
                xo[64 * j] = (f32x4){bflo(w.x), bfhi(w.x), bflo(w.y), bfhi(w.y)} * ps; xo[64 * j + 1] = (f32x4){bflo(w.z), bfhi(w.z), bflo(w.w), bfhi(w.w)} * ps; } }
    }
    ++pc;
}

constexpr int N_PHASES = 1 + DEPTH * 4 + 3 + 3 + 2 + 3 + 1;
#ifndef MK_PER_PHASE
#define MK_PER_PHASE 0
#endif

extern "C" void kernel_launch(void* const* d_in, const int* in_sizes, int n_in, void* d_out, int out_size, void* d_ws, size_t ws_size, hipStream_t stream) {
    static int grid = 0;
    if (grid == 0) {
        if (n_in != 23 || in_sizes[0] != M * D || out_size != M * D || ws_size < WS_END) { fprintf(stderr, "kernel_launch: unexpected problem (n_in %d, in0 %d, out %d, ws %zu < %zu)\n", n_in, n_in > 0 ? in_sizes[0] : -1, out_size, ws_size, (size_t)WS_END); grid = -1; return; }
        int dev = 0, cus = 0, per_cu = 0;
        if (hipGetDevice(&dev) != hipSuccess || hipDeviceGetAttribute(&cus, hipDeviceAttributeMultiprocessorCount, dev) != hipSuccess) { grid = -1; return; }
        if (hipFuncSetAttribute((const void*)mega_fwd, hipFuncAttributeMaxDynamicSharedMemorySize, LDS_BYTES) != hipSuccess) { fprintf(stderr, "kernel_launch: hipFuncSetAttribute failed\n"); grid = -1; return; }
        if (hipOccupancyMaxActiveBlocksPerMultiprocessor(&per_cu, (const void*)mega_fwd, 512, LDS_BYTES) != hipSuccess || per_cu < 1) fprintf(stderr, "kernel_launch: occupancy query says %d\n", per_cu);
        (void)hipGetLastError();
        grid = cus;
    }
    if (grid < 0) return;
    (void)hipMemsetAsync((char*)d_ws + WS_CTL, 0, CTL_ZERO_BYTES, stream);
    Args a{};
    for (int i = 0; i < 23; ++i) a.in[i] = (const float*)d_in[i];
    a.out = (float*)d_out; a.ws = (unsigned char*)d_ws;
#if MK_PER_PHASE
    for (int p = 0; p < N_PHASES; ++p) { a.ph_lo = p; a.ph_hi = p + 1; hipLaunchKernelGGL(mega_fwd, dim3(grid), dim3(512), LDS_BYTES, stream, a); }
#else
    a.ph_lo = 0; a.ph_hi = N_PHASES;
    hipLaunchKernelGGL(mega_fwd, dim3(grid), dim3(512), LDS_BYTES, stream, a);
#endif
}
```

```cpp
#include <hip/hip_runtime.h>
#include <cstdio>
#include <cstdint>

constexpr int D = 2048, SEQ = 16384, M = 32768, DEPTH = 4, DFF = 5632;
constexpr int NHEAD = 64, HD = 32, GRID_W = 64, GROWS = 256, NQKV = 3 * D;
constexpr int DSGU = 4096, SGU_IN = 8192, CHUNK = 128, SGG = 16, SGD = 256;
constexpr int PGD = 512;
constexpr float EPS = 1e-6f;
constexpr float LOG2E = 1.4426950408889634f;
constexpr float QSCALE = 0.17677669529663687f * LOG2E;

typedef unsigned short bf16_t;
#define LAS __attribute__((address_space(3)))
#define GAS __attribute__((address_space(1)))
typedef short bf16x8 __attribute__((ext_vector_type(8)));
typedef float f32x4 __attribute__((ext_vector_type(4)));
typedef float f32x2 __attribute__((ext_vector_type(2)));
typedef unsigned u32x4 __attribute__((ext_vector_type(4)));
typedef unsigned u32x2 __attribute__((ext_vector_type(2)));

__device__ __forceinline__ unsigned cvt_pk_bf16(float lo, float hi) { unsigned r; asm volatile("v_cvt_pk_bf16_f32 %0, %1, %2" : "=v"(r) : "v"(lo), "v"(hi)); return r; }
__device__ __forceinline__ float bflo(unsigned w) { return __uint_as_float(w << 16); }
__device__ __forceinline__ float bfhi(unsigned w) { return __uint_as_float(w & 0xffff0000u); }
__device__ __forceinline__ float bf2f(bf16_t b) { return __uint_as_float(((unsigned)b) << 16); }
__device__ __forceinline__ float rsq(float x) { return __builtin_amdgcn_rsqf(x); }
typedef unsigned long long u64;
constexpr float STAT_SCALE = 4194304.0f, STAT_INV = 1.0f / 4194304.0f;
__device__ __forceinline__ u64 stat_fix(float s) { return (u64)(long long)__float2ll_rn(s * STAT_SCALE); }
__device__ __forceinline__ float stat_f(u64 v) { return ((float)(unsigned)(v >> 32) * 4294967296.0f + (float)(unsigned)v) * STAT_INV; }
__device__ __forceinline__ float stat_get(const u64* p, int r) { return stat_f(p[r]); }
__device__ __forceinline__ void stat_add(u64* p, int r, float s) { atomicAdd(p + r, stat_fix(s)); }

#ifndef PG8_PRIO
#define PG8_PRIO 1
#endif
#ifndef PG8_SP2
#define PG8_SP2 1
#endif
namespace pg8 {
constexpr int BM = 256, BK = 64, HALF = 128, HTB = HALF * BK * 2, STAGE_BYTES = 8 * HTB, NXCD = 8, WGM = 8;
__host__ __device__ __forceinline__ int lds_byte(int r, int c) { const int st = (r >> 4) * 2 + (c >> 5), rr = r & 15, cc = c & 31, ob = rr * 64 + cc * 2; return st * 1024 + (ob ^ (((ob >> 9) & 1) << 5)); }
__host__ __device__ __forceinline__ void stage_rc(int b, int& R, int& C) { const int st = b / 1024, sb = b % 1024, swz = sb ^ (((sb >> 9) & 1) << 5); R = (st >> 1) * 16 + swz / 64; C = (st & 1) * 32 + (swz % 64) / 2; }
__host__ __device__ __forceinline__ int perm32(int rho) { const int n = rho >> 4, i = rho & 15; return 8 * (i >> 2) + 4 * n + (i & 3); }

struct Unit { int pm, pn; };
template <int N_, int K_, int LDA_, int LDB_, int GT_ = 0, int GAB_ = 0, int WGM_ = 8, int ATILE_ = 0> struct Shape { static constexpr int N = N_, K = K_, LDA = LDA_, LDB = LDB_, GT = GT_, GAB = GAB_, WGMS = WGM_, ATILE = ATILE_; };

template <int nM, int nN, int WGMS> struct StaticOrder {
    int G, c;
    __device__ __forceinline__ bool next(int i, Unit& u) const {
        constexpr int nwg = nM * nN;
        const int L = i * G + c; if (L >= nwg) return false;
        int wgid = L; { constexpr int q = nwg / NXCD, r = nwg % NXCD; const int xcd = wgid % NXCD, off = wgid / NXCD; wgid = (xcd < r ? xcd * (q + 1) : r * (q + 1) + (xcd - r) * q) + off; }
        constexpr int nig = WGMS * nN; const int gid = wgid / nig, fm = gid * WGMS, gsz = (nM - fm) < WGMS ? (nM - fm) : WGMS;
        u.pm = fm + ((wgid % nig) % gsz); u.pn = (wgid % nig) / gsz; return true;
    }
};

template <class Epi, class SH>
__device__ __forceinline__ void gemm_phase(LAS unsigned char* lds, const bf16_t* gA, const bf16_t* gBt, int G_, int c_, Epi& E) {
    StaticOrder<32768 / BM, SH::N / BM, SH::WGMS> S; S.G = G_; S.c = c_;
    int tid_ = threadIdx.x; asm volatile("" : "+v"(tid_));
    const int tid = tid_, wid = __builtin_amdgcn_readfirstlane(tid >> 6), lane = tid & 63, wr = wid >> 2, wc = wid & 3, fr = lane & 15, fq = lane >> 4;
    constexpr int nt = SH::K / BK;
    unsigned voffA[2], voffB[2];
#pragma unroll
    for (int i = 0; i < 2; ++i) { int R, C; stage_rc(tid * 16 + i * 8192, R, C); const int Rb = Epi::PERM ? ((R & ~31) + perm32(R & 31)) : R;
        voffA[i] = SH::ATILE ? (unsigned)(((R >> 4) * (SH::LDA / 32) + (C >> 5)) * 1024 + (R & 15) * 64 + (C & 31) * 2) : (unsigned)(R * SH::LDA + C) * 2u;
        static_assert(Epi::PERM, "the weight copies are stored pre-permuted"); (void)Rb;
        voffB[i] = (unsigned)(((R >> 4) * (SH::LDB / 32) + (C >> 5)) * 1024 + (R & 15) * 64 + (C & 31) * 2); }
    const unsigned kstep = 2048u, kstepA = SH::ATILE ? 2048u : (unsigned)(BK * 2);
    constexpr unsigned hA = (unsigned)HALF * SH::LDA * 2, hB = (unsigned)HALF * SH::LDB * 2, tA = 2 * hA, tB = 2 * hB;
    const __amdgpu_buffer_rsrc_t rsA = __builtin_amdgcn_make_buffer_rsrc((void*)gA, 0, -1, 0x00020000), rsB = __builtin_amdgcn_make_buffer_rsrc((void*)gBt, 0, -1, 0x00020000);
    const unsigned ldsw = (unsigned)wid * 1024u;
    const int aoff = lds_byte(wr * 64 + fr, fq * 8), boff = lds_byte(wc * 32 + fr, fq * 8);
#define PG8_APTR(u) ((unsigned)(u).pm * tA + (SH::GT ? (unsigned)((u).pn / (SH::GT ? SH::GT : 1)) * (unsigned)SH::GAB : 0u))
#define PG8_BPTR(u) ((unsigned)(u).pn * tB)
#define PG8_RS_voffA rsA
#define PG8_RS_voffB rsB
#define PG8_SA(b, h) (((b) * 2 + (h)) * HTB)
#define PG8_SB(b, h) ((4 + (b) * 2 + (h)) * HTB)
#define PG8_STAGE(bufoff, gbase, voff) do { _Pragma("unroll") for (int _i = 0; _i < 2; ++_i) \
        __builtin_amdgcn_raw_ptr_buffer_load_lds(PG8_RS_##voff, (LAS unsigned*)(lds + (bufoff) + ldsw + _i * 8192), 16, (int)(voff)[_i], (int)(gbase), 0, 0); } while (0)
#define PG8_LDA(dst, b, h) do { _Pragma("unroll") for (int m = 0; m < 4; ++m) _Pragma("unroll") for (int k = 0; k < 2; ++k) dst[m][k] = *(const LAS bf16x8*)(lds + PG8_SA(b, h) + aoff + m * 2048 + k * 1024); } while (0)
#define PG8_LDB(dst, b, h) do { _Pragma("unroll") for (int n = 0; n < 2; ++n) _Pragma("unroll") for (int k = 0; k < 2; ++k) dst[n][k] = *(const LAS bf16x8*)(lds + PG8_SB(b, h) + boff + n * 2048 + k * 1024); } while (0)
#define PG8_MMA(ai, bj, At, Bt) do { if (PG8_PRIO) __builtin_amdgcn_s_setprio(1); _Pragma("unroll") for (int m = 0; m < 4; ++m) _Pragma("unroll") for (int n = 0; n < 2; ++n) _Pragma("unroll") for (int k = 0; k < 2; ++k) \
        acc[ai][bj][m][n] = __builtin_amdgcn_mfma_f32_16x16x32_bf16(Bt[n][k], At[m][k], acc[ai][bj][m][n], 0, 0, 0); if (PG8_PRIO) __builtin_amdgcn_s_setprio(0); } while (0)
#define PG8_WAIT_V(n) asm volatile("s_waitcnt vmcnt(" #n ")" ::: "memory")
#define PG8_WAIT_L(n) asm volatile("s_waitcnt lgkmcnt(" #n ")" ::: "memory")
#define PG8_BAR __builtin_amdgcn_s_barrier()
#define PG8_SCHED __builtin_amdgcn_sched_barrier(0)
    Unit cur, nxt; int ui = 0;
    if (!S.next(0, cur)) return;
    f32x4 acc[2][2][4][2];
#pragma unroll
    for (int a = 0; a < 2; ++a)
#pragma unroll
        for (int b = 0; b < 2; ++b)
#pragma unroll
            for (int m = 0; m < 4; ++m)
#pragma unroll
                for (int n = 0; n < 2; ++n) acc[a][b][m][n] = (f32x4){0.f, 0.f, 0.f, 0.f};
    bf16x8 At[4][2], B0[2][2], B1[2][2];
    unsigned cA = PG8_APTR(cur), cB = PG8_BPTR(cur);
#if PG8_SP2
    PG8_STAGE(PG8_SB(0, 0), cB, voffB); PG8_STAGE(PG8_SB(0, 1), cB + hB, voffB); PG8_STAGE(PG8_SA(0, 0), cA, voffA); PG8_STAGE(PG8_SA(0, 1), cA + hA, voffA);
    if (wr == 1) PG8_BAR;
    PG8_WAIT_V(2); PG8_BAR;
    PG8_STAGE(PG8_SB(1, 0), cB + kstep, voffB); PG8_STAGE(PG8_SA(1, 0), cA + kstepA, voffA); PG8_STAGE(PG8_SB(1, 1), cB + hB + kstep, voffB);
    PG8_WAIT_V(6); PG8_BAR;
#else
    PG8_STAGE(PG8_SB(0, 0), cB, voffB); PG8_STAGE(PG8_SA(0, 0), cA, voffA); PG8_STAGE(PG8_SB(0, 1), cB + hB, voffB); PG8_STAGE(PG8_SA(0, 1), cA + hA, voffA);
    if (wr == 1) PG8_BAR;
    PG8_WAIT_V(4); PG8_BAR;
    PG8_STAGE(PG8_SB(1, 0), cB + kstep, voffB); PG8_STAGE(PG8_SA(1, 0), cA + kstepA, voffA); PG8_STAGE(PG8_SB(1, 1), cB + hB + kstep, voffB);
    PG8_WAIT_V(6); PG8_BAR;
#endif
    for (;;) {
        const bool has_next = S.next(ui + 1, nxt);
        const unsigned nA = has_next ? PG8_APTR(nxt) : cA, nB = has_next ? PG8_BPTR(nxt) : cB;
        for (int t = 0; t < nt; t += 2) {
            const bool last = (t == nt - 2);
            const unsigned a1 = cA + (unsigned)(t + 1) * kstepA;
            const unsigned a2 = last ? nA : cA + (unsigned)(t + 2) * kstepA, b2 = last ? nB : cB + (unsigned)(t + 2) * kstep;
            const unsigned a3 = a2 + kstepA, b3 = b2 + kstep;
#if PG8_SP2
            PG8_LDB(B0, 0, 0); PG8_LDB(B1, 0, 1); PG8_SCHED; PG8_LDA(At, 0, 0); PG8_STAGE(PG8_SA(1, 1), a1 + hA, voffA);
            PG8_WAIT_V(8); PG8_WAIT_L(0); PG8_BAR; PG8_MMA(0, 0, At, B0); PG8_MMA(0, 1, At, B1); PG8_BAR; PG8_SCHED;
            PG8_LDA(At, 0, 1); PG8_STAGE(PG8_SB(0, 0), b2, voffB); PG8_STAGE(PG8_SB(0, 1), b2 + hB, voffB); PG8_STAGE(PG8_SA(0, 0), a2, voffA);
            PG8_WAIT_V(8); PG8_WAIT_L(0); PG8_BAR; PG8_MMA(1, 0, At, B0); PG8_MMA(1, 1, At, B1); PG8_BAR; PG8_SCHED;
            PG8_LDB(B0, 1, 0); PG8_LDB(B1, 1, 1); PG8_SCHED; PG8_LDA(At, 1, 0); PG8_STAGE(PG8_SA(0, 1), a2 + hA, voffA);
            PG8_WAIT_V(8); PG8_WAIT_L(0); PG8_BAR; PG8_MMA(0, 0, At, B0); PG8_MMA(0, 1, At, B1); PG8_BAR; PG8_SCHED;
            PG8_LDA(At, 1, 1); PG8_STAGE(PG8_SB(1, 0), b3, voffB); PG8_STAGE(PG8_SB(1, 1), b3 + hB, voffB); PG8_STAGE(PG8_SA(1, 0), a3, voffA);
            PG8_WAIT_V(8); PG8_WAIT_L(0); PG8_BAR; PG8_MMA(1, 0, At, B0); PG8_MMA(1, 1, At, B1); PG8_BAR; PG8_SCHED;
#else
            PG8_LDB(B0, 0, 0); PG8_SCHED; PG8_LDA(At, 0, 0); PG8_STAGE(PG8_SA(1, 1), a1 + hA, voffA);
            PG8_WAIT_L(8); PG8_BAR; PG8_WAIT_L(0); PG8_MMA(0, 0, At, B0); PG8_BAR; PG8_SCHED;
            PG8_LDB(B1, 0, 1); PG8_STAGE(PG8_SB(0, 0), b2, voffB);
            PG8_BAR; PG8_WAIT_L(0); PG8_MMA(0, 1, At, B1); PG8_BAR;
            PG8_LDA(At, 0, 1); PG8_STAGE(PG8_SA(0, 0), a2, voffA);
            PG8_BAR; PG8_WAIT_L(0); PG8_MMA(1, 0, At, B0); PG8_BAR; PG8_SCHED;
            PG8_STAGE(PG8_SB(0, 1), b2 + hB, voffB);
            PG8_WAIT_V(6); PG8_BAR; PG8_MMA(1, 1, At, B1); PG8_BAR;
            PG8_LDB(B0, 1, 0); PG8_SCHED; PG8_LDA(At, 1, 0); PG8_STAGE(PG8_SA(0, 1), a2 + hA, voffA);
            PG8_WAIT_L(8); PG8_BAR; PG8_WAIT_L(0); PG8_MMA(0, 0, At, B0); PG8_BAR; PG8_SCHED;
            PG8_LDB(B1, 1, 1); PG8_STAGE(PG8_SB(1, 0), b3, voffB);
            PG8_BAR; PG8_WAIT_L(0); PG8_MMA(0, 1, At, B1); PG8_BAR;
            PG8_LDA(At, 1, 1); PG8_STAGE(PG8_SA(1, 0), a3, voffA);
            PG8_BAR; PG8_WAIT_L(0); PG8_MMA(1, 0, At, B0); PG8_BAR; PG8_SCHED;
            PG8_STAGE(PG8_SB(1, 1), b3 + hB, voffB);
            PG8_WAIT_V(6); PG8_BAR; PG8_MMA(1, 1, At, B1); PG8_BAR;
#endif
        }
        if (wr == 0) PG8_BAR;
        E(acc, cur, wr, wc, fr, fq);
        if (!has_next) break;
        if (!Epi::ZEROES)
#pragma unroll
        for (int a = 0; a < 2; ++a)
#pragma unroll
            for (int b = 0; b < 2; ++b)
#pragma unroll
                for (int m = 0; m < 4; ++m)
#pragma unroll
                    for (int n = 0; n < 2; ++n) { double z0, z1; asm volatile("v_mov_b64 %0, 0" : "=v"(z0)); asm volatile("v_mov_b64 %0, 0" : "=v"(z1));
                        const f32x2 l = __builtin_bit_cast(f32x2, z0), h = __builtin_bit_cast(f32x2, z1); acc[a][b][m][n] = (f32x4){l.x, l.y, h.x, h.y}; }
        cur = nxt; cA = nA; cB = nB; ++ui;
        if (wr == 1) PG8_BAR;
    }
    PG8_WAIT_V(0);
    PG8_BAR;
#undef PG8_APTR
#undef PG8_BPTR
#undef PG8_RS_voffA
#undef PG8_RS_voffB
#undef PG8_SA
#undef PG8_SB
#undef PG8_STAGE
#undef PG8_LDA
#undef PG8_LDB
#undef PG8_MMA
#undef PG8_WAIT_V
#undef PG8_WAIT_L
#undef PG8_BAR
#undef PG8_SCHED
}
}

__device__ __forceinline__ f32x2 gelu_pk(f32x2 v) {
    const f32x2 av = __builtin_elementwise_abs(v), d = av * 0.2316418882f + 1.0f;
    f32x2 t; t.x = __builtin_amdgcn_rcpf(d.x); t.y = __builtin_amdgcn_rcpf(d.y);
    f32x2 q = t * 0.5307027145f + (-0.7265760135f); q = q * t + 0.7107068705f; q = q * t + (-0.142248368f); q = q * t + 0.127414796f; q = q * t;
    const f32x2 s = (v * v) * (-0.72134752044f);
    f32x2 e; e.x = __builtin_amdgcn_exp2f(s.x); e.y = __builtin_amdgcn_exp2f(s.y);
    const f32x2 m = v * (q * e), r = v - m;
    f32x2 o; o.x = v.x < 0.f ? m.x : r.x; o.y = v.y < 0.f ? m.y : r.y; return o;
}
__device__ __forceinline__ float silu_f(float x) { return x * __builtin_amdgcn_rcpf(1.0f + __builtin_amdgcn_exp2f(-LOG2E * x)); }

__device__ __forceinline__ float row_ps(const u64* s1, bool has1, int r) { const float p = rsq(stat_f(s1[r]) * (1.0f / D) + EPS); return has1 ? p : 1.0f; }
__device__ __forceinline__ float row_cf(const u64* ss, const u64* s1, bool has1, int r) { const float ps = row_ps(s1, has1, r); return ps * rsq(ps * ps * stat_f(ss[r]) * (1.0f / D) + EPS); }

struct EpiSwiGLU {
    static constexpr bool PERM = true, ZEROES = true;
    bf16_t* O; const u64* ss; const u64* s1; bool has1; int cf_pm; float cfv[2][4];
    __device__ __forceinline__ void operator()(f32x4 (&acc)[2][2][4][2], const pg8::Unit& u, int wr, int wc, int fr, int fq) {
        const int row0 = u.pm * 256 + wr * 64 + fr;
        if (u.pm != cf_pm) { cf_pm = u.pm;
#pragma unroll
        for (int ai = 0; ai < 2; ++ai)
#pragma unroll
            for (int m = 0; m < 4; ++m) cfv[ai][m] = row_cf(ss, s1, has1, row0 + ai * 128 + m * 16); }
        char* const obase = (char*)O + ((size_t)(u.pm * 16 + wr * 4) * (DFF / 32) + u.pn * 4 + wc) * 1024 + fr * 64 + fq * 16;
#pragma unroll
        for (int ai = 0; ai < 2; ++ai)
#pragma unroll
            for (int m = 0; m < 4; ++m) { const float cf = cfv[ai][m], c1 = -LOG2E * cf, ic2 = __builtin_amdgcn_rcpf(cf * cf);
                u32x4 w;
#pragma unroll
                for (int n = 0; n < 2; ++n) { const f32x4 g = acc[ai][0][m][n], uu = acc[ai][1][m][n];
                    const f32x2 ga = {g[0], g[1]}, gb = {g[2], g[3]}, ua = {uu[0], uu[1]}, ub = {uu[2], uu[3]};
                    const f32x2 ta = ga * c1, tb = gb * c1; f32x2 ea, eb; ea.x = __builtin_amdgcn_exp2f(fminf(ta.x, 40.f)); ea.y = __builtin_amdgcn_exp2f(fminf(ta.y, 40.f)); eb.x = __builtin_amdgcn_exp2f(fminf(tb.x, 40.f)); eb.y = __builtin_amdgcn_exp2f(fminf(tb.y, 40.f));
                    const f32x2 da = ea * ic2 + ic2, db = eb * ic2 + ic2, pp = da * db; f32x2 rr; rr.x = __builtin_amdgcn_rcpf(pp.x); rr.y = __builtin_amdgcn_rcpf(pp.y);
                    const f32x2 oa = (ga * ua) * (rr * db), ob = (gb * ub) * (rr * da);
                    if (n == 0) { w.x = cvt_pk_bf16(oa.x, oa.y); w.y = cvt_pk_bf16(ob.x, ob.y); } else { w.z = cvt_pk_bf16(oa.x, oa.y); w.w = cvt_pk_bf16(ob.x, ob.y); } }
                __builtin_nontemporal_store(w, (u32x4*)(obase + (size_t)(ai * 8 + m) * (DFF / 32) * 1024));
#pragma unroll
                for (int bj = 0; bj < 2; ++bj)
#pragma unroll
                    for (int n = 0; n < 2; ++n) { double z0, z1; asm volatile("v_mov_b64 %0, 0" : "=v"(z0)); asm volatile("v_mov_b64 %0, 0" : "=v"(z1));
                        const f32x2 l = __builtin_bit_cast(f32x2, z0), h = __builtin_bit_cast(f32x2, z1); acc[ai][bj][m][n] = (f32x4){l.x, l.y, h.x, h.y}; } }
    }
};
__device__ __forceinline__ size_t xb_off(int r, int c) { return ((size_t)(r >> 4) * (D / 32) + (c >> 5)) * 512 + (r & 15) * 32 + (c & 31); }
struct EpiResid {
    static constexpr bool PERM = true, ZEROES = false;
    bf16_t* XB; const u64* s1_in; bool has1; u64* ss_out; const float* gout; u64* s1_out;
    __device__ __forceinline__ void operator()(const f32x4 (&acc)[2][2][4][2], const pg8::Unit& u, int wr, int wc, int fr, int fq) {
        const int row0 = u.pm * 256 + wr * 64 + fr, col0 = u.pn * 256 + wc * 32 + 8 * fq;
        float psv[2][4];
#pragma unroll
        for (int ai = 0; ai < 2; ++ai)
#pragma unroll
            for (int m = 0; m < 4; ++m) psv[ai][m] = row_ps(s1_in, has1, row0 + ai * 128 + m * 16);
#define RESID_ROW(ai, m, XROW) do { const int r = row0 + ai * 128 + m * 16; const float ps = psv[ai][m]; float sA = 0.f, sB = 0.f; \
_Pragma("unroll") \
                for (int bj = 0; bj < 2; ++bj) { const u32x4 xw = XROW[bj]; \
                    f32x4 v0 = (f32x4){bflo(xw.x), bfhi(xw.x), bflo(xw.y), bfhi(xw.y)} * ps + acc[ai][bj][m][0], v1 = (f32x4){bflo(xw.z), bfhi(xw.z), bflo(xw.w), bfhi(xw.w)} * ps + acc[ai][bj][m][1]; \
                    if (gout) { sB += (v0[0] * v0[0] + v0[1] * v0[1]) + (v0[2] * v0[2] + v0[3] * v0[3]) + (v1[0] * v1[0] + v1[1] * v1[1]) + (v1[2] * v1[2] + v1[3] * v1[3]); \
                        v0 = v0 * *(const f32x4*)(gout + col0 + bj * 128); v1 = v1 * *(const f32x4*)(gout + col0 + bj * 128 + 4); } \
                    sA += (v0[0] * v0[0] + v0[1] * v0[1]) + (v0[2] * v0[2] + v0[3] * v0[3]) + (v1[0] * v1[0] + v1[1] * v1[1]) + (v1[2] * v1[2] + v1[3] * v1[3]); \
                    u32x4 w; w.x = cvt_pk_bf16(v0[0], v0[1]); w.y = cvt_pk_bf16(v0[2], v0[3]); w.z = cvt_pk_bf16(v1[0], v1[1]); w.w = cvt_pk_bf16(v1[2], v1[3]); \
                    *(u32x4*)(XB + xb_off(r, col0 + bj * 128)) = w; } \
                sA += __shfl_xor(sA, 16); sA += __shfl_xor(sA, 32); \
                if (gout) { sB += __shfl_xor(sB, 16); sB += __shfl_xor(sB, 32); } \
                if (fq == 0) { stat_add(ss_out, r, sA); if (gout) stat_add(s1_out, r, sB); } } while (0)
        u32x4 x0[4][2], x1[4][2];
#pragma unroll
        for (int m = 0; m < 4; ++m)
#pragma unroll
            for (int bj = 0; bj < 2; ++bj) x0[m][bj] = *(const u32x4*)(XB + xb_off(row0 + m * 16, col0 + bj * 128));
#pragma unroll
        for (int m = 0; m < 4; ++m) { RESID_ROW(0, m, x0[m]);
            if (m & 1) {
#pragma unroll
                for (int mm = m - 1; mm <= m; ++mm)
#pragma unroll
                    for (int bj = 0; bj < 2; ++bj) x1[mm][bj] = *(const u32x4*)(XB + xb_off(row0 + 128 + mm * 16, col0 + bj * 128)); } }
        asm volatile("" ::: "memory");
#pragma unroll
        for (int m = 0; m < 4; ++m) RESID_ROW(1, m, x1[m]);
#undef RESID_ROW
        { asm volatile("" ::: "memory"); }
    }
};
struct EpiQKV {
    static constexpr bool PERM = true, ZEROES = false;
    bf16_t* QKVb; const u64* ss; const float* qkg;
    __device__ __forceinline__ void operator()(const f32x4 (&acc)[2][2][4][2], const pg8::Unit& u, int wr, int wc, int fr, int fq) {
        float cfv[2][4];
        const int t = u.pn >> 3, row0 = u.pm * 256 + wr * 64 + fr, col0 = (u.pn & 7) * 256 + wc * 32 + 8 * fq;
        bf16_t* O = QKVb + (size_t)t * M * D;
        f32x4 ga = {1.f, 1.f, 1.f, 1.f}, gb = {1.f, 1.f, 1.f, 1.f};
#pragma unroll
        for (int ai = 0; ai < 2; ++ai)
#pragma unroll
            for (int m = 0; m < 4; ++m) cfv[ai][m] = row_cf(ss, ss, false, row0 + ai * 128 + m * 16);
        if (t < 2) { const float* gp = qkg + t * 64 + 8 * fq; ga = *(const f32x4*)gp; gb = *(const f32x4*)(gp + 4); if (t == 0) { ga = ga * QSCALE; gb = gb * QSCALE; } }
#pragma unroll
        for (int ai = 0; ai < 2; ++ai)
#pragma unroll
            for (int m = 0; m < 4; ++m) { const int r = row0 + ai * 128 + m * 16; const float cf = cfv[ai][m];
#pragma unroll
                for (int bj = 0; bj < 2; ++bj) { f32x4 v0 = acc[ai][bj][m][0] * cf, v1 = acc[ai][bj][m][1] * cf;
                    if (t < 2) { float q = (v0[0] * v0[0] + v0[1] * v0[1]) + (v0[2] * v0[2] + v0[3] * v0[3]) + (v1[0] * v1[0] + v1[1] * v1[1]) + (v1[2] * v1[2] + v1[3] * v1[3]);
                        q += __shfl_xor(q, 16); q += __shfl_xor(q, 32); const float hr = rsq(q * (1.0f / HD) + EPS); v0 = v0 * hr * ga; v1 = v1 * hr * gb; }
                    u32x4 w; w.x = cvt_pk_bf16(v0[0], v0[1]); w.y = cvt_pk_bf16(v0[2], v0[3]); w.z = cvt_pk_bf16(v1[0], v1[1]); w.w = cvt_pk_bf16(v1[2], v1[3]);
                    *(u32x4*)(O + (size_t)r * D + col0 + bj * 128) = w; } }
    }
};
struct EpiSguIn {
    static constexpr bool PERM = true, ZEROES = false;
    bf16_t* U; bf16_t* V; const u64* ss; u64* ssv;
    __device__ __forceinline__ void operator()(const f32x4 (&acc)[2][2][4][2], const pg8::Unit& u, int wr, int wc, int fr, int fq) {
        const int t = u.pn >> 4, row0 = u.pm * 256 + wr * 64 + fr, col0 = (u.pn & 15) * 256 + wc * 32 + 8 * fq;
        bf16_t* O = t ? V : U;
        float cfv[2][4];
#pragma unroll
        for (int ai = 0; ai < 2; ++ai)
#pragma unroll
            for (int m = 0; m < 4; ++m) cfv[ai][m] = row_cf(ss, ss, false, row0 + ai * 128 + m * 16);
#pragma unroll
        for (int ai = 0; ai < 2; ++ai)
#pragma unroll
            for (int m = 0; m < 4; ++m) { const int r = row0 + ai * 128 + m * 16; const float cf = cfv[ai][m]; float sv = 0.f;
#pragma unroll
                for (int bj = 0; bj < 2; ++bj) { const f32x4 v0 = acc[ai][bj][m][0] * cf, v1 = acc[ai][bj][m][1] * cf;
                    const f32x2 a = gelu_pk((f32x2){v0[0], v0[1]}), b = gelu_pk((f32x2){v0[2], v0[3]}), c = gelu_pk((f32x2){v1[0], v1[1]}), d = gelu_pk((f32x2){v1[2], v1[3]});
                    sv += (a.x * a.x + a.y * a.y) + (b.x * b.x + b.y * b.y) + (c.x * c.x + c.y * c.y) + (d.x * d.x + d.y * d.y);
                    u32x4 w; w.x = cvt_pk_bf16(a.x, a.y); w.y = cvt_pk_bf16(b.x, b.y); w.z = cvt_pk_bf16(c.x, c.y); w.w = cvt_pk_bf16(d.x, d.y);
                    *(u32x4*)(O + (size_t)r * DSGU + col0 + bj * 128) = w; }
                if (t) { sv += __shfl_xor(sv, 16); sv += __shfl_xor(sv, 32); if (fq == 0) stat_add(ssv, r, sv); } }
    }
};

constexpr size_t MiB = 1u << 20;
constexpr size_t WS_CTL = 0, CTL_ZERO_BYTES = 5 * MiB;
constexpr int CW_BAR = 1024;
constexpr size_t STAT_OFF = 65536;
constexpr int ST_F1 = 0, ST_S1 = 5, ST_MIX = 10, ST_F2 = 14, ST_V = 18, NSTAT = 19;
static_assert(STAT_OFF + (size_t)NSTAT * M * 8 <= CTL_ZERO_BYTES, "stats inside the memset region");
constexpr size_t WS_PAR = CTL_ZERO_BYTES;
constexpr int PAR_GOUT = 0, PAR_QG = 8192, PAR_KG = 8256  , PAR_RPB = 8320, PAR_VG = 67840, PAR_BS = 71936, PAR_WS = 73984, PAR_END = 336128;
static_assert(WS_PAR + (size_t)PAR_END * 4 <= 8 * MiB, "params region");
constexpr size_t WS_W = 8 * MiB;
constexpr size_t EL_FFN = (size_t)3 * D * DFF, EL_GU = (size_t)2 * D * DFF;
constexpr size_t EL_NA0 = 8 * EL_FFN, EL_NA = (size_t)4 * D * D, EL_QKV = (size_t)3 * D * D;
constexpr size_t EL_SGU = EL_NA0 + 2 * EL_NA, EL_SIN = (size_t)D * SGU_IN, EL_SOUT = (size_t)DSGU * D, EL_WS = (size_t)SGG * CHUNK * CHUNK;
constexpr size_t EL_POOL = EL_SGU + EL_SIN + EL_SOUT + EL_WS, EL_END = EL_POOL + (size_t)4 * PGD * PGD;
constexpr size_t WS_XB = WS_W + ((EL_END * 2 + MiB - 1) / MiB) * MiB;
constexpr size_t WS_BIG = WS_XB + (size_t)M * D * 2;
constexpr size_t WS_END = WS_BIG + 512 * MiB;

constexpr int RING_BYTES = 131072, MISC_OFF = RING_BYTES + 320, LDS_BYTES = 147456;

#define XB_TMO      128
#define XB_XCNT(j)  (256  + 64 * (j))
#define XB_XSUB(j)  (1280 + 64 * (j))
#define XB_XGEN(j)  (2304 + 64 * (j))
#define XB_TOP      3328
#define XB_TOPGEN   3392
#define XCD_BAR_WORDS 3456
#define XB_SPIN_CAP (1u << 18)
__device__ __forceinline__ unsigned xb_ld(unsigned* p)              { return __hip_atomic_load(p, __ATOMIC_RELAXED, __HIP_MEMORY_SCOPE_AGENT); }
__device__ __forceinline__ unsigned xb_add(unsigned* p, unsigned v) { return __hip_atomic_fetch_add(p, v, __ATOMIC_RELAXED, __HIP_MEMORY_SCOPE_AGENT); }
__device__ __forceinline__ unsigned xb_xcc_id() { return (unsigned)__builtin_amdgcn_s_getreg((3 << 11) | 20) & 0xFu; }
#define XB_SPIN(cond, bar) do { unsigned _sp = 0; while (cond) { __builtin_amdgcn_s_sleep(1); \
    if ((++_sp & 255u) == 0u) { if (xb_ld(&(bar)[XB_TMO])) break; if (_sp > XB_SPIN_CAP) { atomicAdd(&(bar)[XB_TMO], 1u); break; } } } } while (0)
struct XcdBarrier { unsigned* bar; unsigned x; volatile LAS unsigned* st; };
__device__ __forceinline__ XcdBarrier xcd_barrier_post(unsigned* bar, volatile LAS unsigned* st) {
    XcdBarrier b; b.bar = bar; b.x = xb_xcc_id(); b.st = st;
    if (threadIdx.x == 0) (void)xb_add(&bar[XB_XCNT(b.x)], 1u);
    return b;
}
__device__ __forceinline__ void xcd_barrier_complete(unsigned* bar, unsigned x, unsigned& nloc, unsigned& nx) {
    const unsigned G = gridDim.x * gridDim.y * gridDim.z;
    unsigned sum, cnt, mine, sp = 0u;
    for (;;) {
        sum = 0u; cnt = 0u; mine = 0u;
#pragma unroll
        for (unsigned j = 0; j < 16; ++j) { const unsigned c = xb_ld(&bar[XB_XCNT(j)]); sum += c; cnt += (c > 0u) ? 1u : 0u; mine = (j == x) ? c : mine; }
        if (sum == G) break;
        __builtin_amdgcn_s_sleep(1);
        if ((++sp & 255u) == 0u) { if (xb_ld(&bar[XB_TMO])) break; if (sp > XB_SPIN_CAP) { atomicAdd(&bar[XB_TMO], 1u); break; } }
    }
    nloc = mine > 0u ? mine : 1u; nx = cnt > 0u ? cnt : 1u;
}
__device__ __forceinline__ void xcd_barrier(const XcdBarrier& b) {
    asm volatile("s_waitcnt vmcnt(0)" ::: "memory");
    __syncthreads();
    if (threadIdx.x == 0) {
        unsigned* bar = b.bar;
        __builtin_amdgcn_s_waitcnt(0);
        unsigned nloc = b.st[0], nx = b.st[1];
        if (nloc == 0u) { xcd_barrier_complete(bar, b.x, nloc, nx); b.st[0] = nloc; b.st[1] = nx; }
        const unsigned old = xb_add(&bar[XB_XSUB(b.x)], 1u);
        const unsigned gen = old / nloc;
        if (old + 1u == (gen + 1u) * nloc) {
            __builtin_amdgcn_fence(__ATOMIC_RELEASE, "agent");
            asm volatile("s_waitcnt vmcnt(0)" ::: "memory");
            const unsigned og = xb_add(&bar[XB_TOP], 1u);
            const unsigned tg = og / nx;
            if (og + 1u == (tg + 1u) * nx) xb_add(&bar[XB_TOPGEN], 1u);
            else XB_SPIN(xb_ld(&bar[XB_TOPGEN]) == tg, bar);
            __builtin_amdgcn_fence(__ATOMIC_ACQUIRE, "agent");
            xb_add(&bar[XB_XGEN(b.x)], 1u);
            asm volatile("s_waitcnt vmcnt(0)" ::: "memory");
        } else {
            XB_SPIN(xb_ld(&bar[XB_XGEN(b.x)]) == gen, bar);
            __builtin_amdgcn_fence(__ATOMIC_ACQUIRE, "agent");
            asm volatile("s_waitcnt vmcnt(0)" ::: "memory");
        }
    }
    __syncthreads();
}

struct TrDesc { const float* W; bf16_t* WT; const float* gain; const float* nscale; float scale; int N, ldt, row_off, ilv, k0, n0; };
__device__ __forceinline__ void tr_set(TrDesc& d, const float* W, int K, int N, bf16_t* WT, int ldt, int row_off, int ilv, const float* gain, const float* nscale, float scale, int item) {
    const int nblk = N / 32, kb = item / nblk, nb = item % nblk; (void)K;
    d.W = W; d.WT = WT; d.gain = gain; d.nscale = nscale; d.scale = scale; d.N = N; d.ldt = ldt; d.row_off = row_off; d.ilv = ilv; d.k0 = 64 * kb; d.n0 = 32 * nb;
}
__device__ __forceinline__ void tr_load(const TrDesc& d, float (&v)[32], int lane) {
#pragma unroll
    for (int i = 0; i < 32; ++i) v[i] = d.W[(size_t)(d.k0 + 2 * i + (lane >> 5)) * d.N + d.n0 + (lane & 31)];
}
__device__ __forceinline__ void tr_store(const TrDesc& d, const float (&v)[32], LAS float* scr, int lane) {
    const float ns = (d.nscale ? d.nscale[d.n0 + (lane & 31)] : 1.0f) * d.scale;
#pragma unroll
    for (int i = 0; i < 32; ++i) { const int kk = 2 * i + (lane >> 5); const float gk = d.gain ? d.gain[d.k0 + kk] : 1.0f; scr[kk * 33 + (lane & 31)] = v[i] * (gk * ns); }
    asm volatile("s_waitcnt lgkmcnt(0)" ::: "memory");
    const int c = lane & 7;
    const int rbase = d.ilv < 0 ? d.row_off + d.n0 : (d.n0 >> 7) * 256 + d.ilv * 128 + (d.n0 & 127);
#pragma unroll
    for (int j = 0; j < 4; ++j) { const int n = (lane >> 3) + 8 * j; const LAS float* sp = scr + (8 * c) * 33 + n;
        u32x4 o; o.x = cvt_pk_bf16(sp[0 * 33], sp[1 * 33]); o.y = cvt_pk_bf16(sp[2 * 33], sp[3 * 33]); o.z = cvt_pk_bf16(sp[4 * 33], sp[5 * 33]); o.w = cvt_pk_bf16(sp[6 * 33], sp[7 * 33]);
        const int R = rbase + 16 * ((n >> 2) & 1) + 4 * (n >> 3) + (n & 3);
        __builtin_nontemporal_store(o, (u32x4*)(d.WT + ((size_t)(R >> 4) * (d.ldt >> 5) + (d.k0 >> 5) + (c >> 2)) * 512 + (R & 15) * 32 + 8 * (c & 3))); }
    asm volatile("s_waitcnt lgkmcnt(0)" ::: "memory");
}

struct Args { const float* in[23]; float* out; unsigned char* ws; int ph_lo, ph_hi; };

__device__ __forceinline__ float wave_sum(float v) {
#pragma unroll
    for (int o = 1; o < 64; o <<= 1) v += __shfl_xor(v, o);
    return v;
}

__global__ void __launch_bounds__(512, 2) mega_fwd(Args a) {
    extern __shared__ __attribute__((aligned(16))) unsigned char lds_raw[];
    LAS unsigned char* lds = (LAS unsigned char*)lds_raw;
    volatile LAS unsigned* MISC = (volatile LAS unsigned*)(lds + MISC_OFF);
    const int tid = threadIdx.x, lane = tid & 63, wave = __builtin_amdgcn_readfirstlane(tid >> 6);
    const int G = gridDim.x, bx = blockIdx.x;
    const int vcu = (G % 8 == 0) ? (bx % 8) * (G / 8) + bx / 8 : bx;
    const int gw = vcu * 8 + wave, NGW = G * 8;
    unsigned char* ws = a.ws;
    unsigned* ctl = (unsigned*)(ws + WS_CTL);
    u64* stat = (u64*)(ws + STAT_OFF);
    float* par = (float*)(ws + WS_PAR);
    bf16_t* Wb = (bf16_t*)(ws + WS_W);
    bf16_t* XB = (bf16_t*)(ws + WS_XB);
    bf16_t* BIG = (bf16_t*)(ws + WS_BIG);
    float* X = a.out;
    for (int u = tid; u < (LDS_BYTES - RING_BYTES) / 4; u += 512) ((LAS unsigned*)(lds + RING_BYTES))[u] = 0u;
    __syncthreads();
    XcdBarrier bar = xcd_barrier_post(ctl + CW_BAR, MISC + 8);
    const int lo = a.ph_lo, hi = a.ph_hi;
    int pc = 0;
#ifndef PHMASK
#define PHMASK 0xffff
#endif
#define EN(k) (((PHMASK) >> (k)) & 1)
#define PH_ON (pc >= lo && pc < hi)
#define PH_END do { if (pc + 1 < hi) xcd_barrier(bar); } while (0)
#define STAT(i) (stat + (size_t)(i) * M)

    if (PH_ON && EN(0)) {
        LAS float* scr = (LAS float*)(lds + wave * 16384);
        constexpr int IT_FFN = 5632, N_FFN = 24 * IT_FFN, IT_QKV = 32 * 192, IT_WO = 32 * 64, IT_SIN = 32 * 256, IT_SOUT = 64 * 64, IT_POOL = 8 * 16;
        constexpr int N_ITEMS = N_FFN + 2 * (IT_QKV + IT_WO) + IT_SIN + IT_SOUT + 4 * IT_POOL;
#define TR_DECODE(IT, DD) do { int r = (IT); \
            if (r < N_FFN) { const int mat = r / IT_FFN, f = mat / 3, k = mat % 3, layer_ = f >> 1, which_ = f & 1; r -= mat * IT_FFN; bf16_t* base = Wb + (size_t)f * EL_FFN; \
                if (k < 2) tr_set(DD, a.in[(which_ ? 7 : 2) + k] + (size_t)layer_ * D * DFF, D, DFF, base, D, 0, k, a.in[which_ ? 6 : 1] + (size_t)layer_ * D, nullptr, 1.0f, r); \
                else tr_set(DD, a.in[which_ ? 9 : 4] + (size_t)layer_ * DFF * D, DFF, D, base + EL_GU, DFF, 0, -1, nullptr, nullptr, 0.5f, r); break; } \
            r -= N_FFN; \
            if (r < 2 * (IT_QKV + IT_WO)) { const int j = r / (IT_QKV + IT_WO); r -= j * (IT_QKV + IT_WO); \
                if (r < IT_QKV) tr_set(DD, a.in[11] + (size_t)j * D * NQKV, D, NQKV, Wb + EL_NA0 + j * EL_NA, D, 0, -1, a.in[5] + (size_t)(3 * j) * D, nullptr, 1.0f, r); \
                else tr_set(DD, a.in[15] + (size_t)j * D * D, D, D, Wb + EL_NA0 + j * EL_NA + EL_QKV, D, 0, -1, nullptr, nullptr, 1.0f, r - IT_QKV); break; } \
            r -= 2 * (IT_QKV + IT_WO); \
            if (r < IT_SIN) { tr_set(DD, a.in[16], D, SGU_IN, Wb + EL_SGU, D, 0, -1, a.in[5] + (size_t)1 * D, nullptr, 1.0f, r); break; } r -= IT_SIN; \
            if (r < IT_SOUT) { tr_set(DD, a.in[20], DSGU, D, Wb + EL_SGU + EL_SIN, DSGU, 0, -1, nullptr, nullptr, 1.0f, r); break; } r -= IT_SOUT; \
            { const int gp = r / IT_POOL; r -= gp * IT_POOL; \
              tr_set(DD, a.in[21] + (size_t)gp * PGD * PGD, PGD, PGD, Wb + EL_POOL, PGD, gp * PGD, -1, a.in[5] + (size_t)2 * D + gp * PGD, a.in[22] + gp * PGD, 1.0f, r); } } while (0)
        { TrDesc d0, d1; float v0[32], v1[32]; int it = gw; bool h0 = it < N_ITEMS;
          if (h0) { TR_DECODE(it, d0); tr_load(d0, v0, lane); }
          while (h0) {
              const int it1 = it + NGW; const bool h1 = it1 < N_ITEMS;
              if (h1) { TR_DECODE(it1, d1); tr_load(d1, v1, lane); }
              tr_store(d0, v0, scr, lane);
              if (!h1) break;
              it = it1 + NGW; h0 = it < N_ITEMS;
              if (h0) { TR_DECODE(it, d0); tr_load(d0, v0, lane); }
              tr_store(d1, v1, scr, lane);
          } }
#undef TR_DECODE
        { const float* wsrc = a.in[18]; bf16_t* wdst = Wb + EL_SGU + EL_SIN + EL_SOUT;
          for (int i = (gw * 64 + lane) * 2; i < (int)EL_WS; i += NGW * 128) *(unsigned*)(wdst + i) = cvt_pk_bf16(wsrc[i], wsrc[i + 1]); }
        { const int gt = gw * 64 + lane, NT = NGW * 64;
          for (int i = gt; i < 8192; i += NT) par[PAR_GOUT + i] = a.in[10][i];
          for (int i = gt; i < 64; i += NT) { par[PAR_QG + i] = a.in[12][i]; par[PAR_KG + i] = a.in[13][i]; }
          for (int i = gt; i < 59520; i += NT) par[PAR_RPB + i] = a.in[14][i] * LOG2E;
          for (int i = gt; i < 4096; i += NT) par[PAR_VG + i] = a.in[17][i];
          for (int i = gt; i < 2048; i += NT) par[PAR_BS + i] = a.in[19][i];
          for (int i = gt; i < 262144; i += NT) par[PAR_WS + i] = a.in[18][i]; }
        for (int m2 = gw; m2 < M / 2; m2 += NGW) {
            const int m = 2 * m2 + (lane >> 5), hl = lane & 31;
            const f32x4* xr = (const f32x4*)(a.in[0] + (size_t)m * D) + 2 * hl; bf16_t* bo = XB + xb_off(m, 8 * hl);
            float s = 0.f;
#pragma unroll
            for (int j = 0; j < 8; ++j) { const f32x4 v0 = xr[64 * j], v1 = xr[64 * j + 1];
                s += (v0[0] * v0[0] + v0[1] * v0[1]) + (v0[2] * v0[2] + v0[3] * v0[3]) + (v1[0] * v1[0] + v1[1] * v1[1]) + (v1[2] * v1[2] + v1[3] * v1[3]);
                u32x4 w; w.x = cvt_pk_bf16(v0[0], v0[1]); w.y = cvt_pk_bf16(v0[2], v0[3]); w.z = cvt_pk_bf16(v1[0], v1[1]); w.w = cvt_pk_bf16(v1[2], v1[3]); *(u32x4*)(bo + (size_t)j * 8 * 512) = w; }
#pragma unroll
            for (int o = 1; o < 32; o <<= 1) s += __shfl_xor(s, o);
            if (hl == 0) STAT(ST_F1 + 0)[m] = stat_fix(s);
        }
        PH_END;
    }
    ++pc;

    for (int step = 0; step < 2 * DEPTH; ++step) {
        const int layer = step >> 1, which = step & 1, kind = layer % 3, jm = layer / 3;
        if (which == 1) {
            if (kind == 0) {
                bf16_t* Q = BIG; bf16_t* Kb = BIG + (size_t)M * D; bf16_t* Vb = BIG + (size_t)2 * M * D; bf16_t* Ob = BIG + (size_t)3 * M * D;
                if (PH_ON && EN(6)) {

                    EpiQKV E{Q, STAT(ST_MIX + layer), par + PAR_QG + jm * HD};
                    pg8::gemm_phase<EpiQKV, pg8::Shape<NQKV, D, D, D, 0, 0, 8, 1>>(lds, XB, Wb + EL_NA0 + jm * EL_NA, G, bx, E);
                    PH_END;
                }
                ++pc;
                if (PH_ON && EN(2)) {
                    constexpr int VT_STRIDE = 1928, VT_OFF = 15 * 64 * 64, BI_OFF = VT_OFF + 32 * VT_STRIDE;
                    static_assert(BI_OFF + 529 * 4 <= RING_BYTES, "attention LDS");
                    int tq_ = threadIdx.x; asm volatile("" : "+v"(tq_));
                    const int tq = tq_, l = tq & 63, q = l & 15, g = l >> 4;
                    const float* rpbj = par + PAR_RPB + jm * NHEAD * 465;
                    for (int un = vcu; un < 2 * NHEAD * 32; un += G) {
                        const int h = un & 63, rb = (un >> 6) & 31, b = un >> 11;
                        const int R0 = rb * 8, KR0 = min(max(R0 - 4, 0), GROWS - 15);
                        const int r = R0 + wave, rs = min(max(r - 4, 0), GROWS - 8), krb = rs - KR0, drb = rs - r + 7;
                        bf16x8 qf[4];
#pragma unroll
                        for (int jb = 0; jb < 4; ++jb) qf[jb] = *(const bf16x8*)(Q + ((size_t)(b << 14) + r * 64 + 16 * jb + q) * D + h * 32 + 8 * g);
                        __syncthreads();
#pragma unroll
                        for (int e = 0; e < 4; ++e) { const int idx = tq + 512 * e;
                            if (idx < 15 * 32 * 4) { const int tok = (idx >> 2) * 2, ch = idx & 3; const size_t go = ((size_t)(b << 14) + KR0 * 64 + tok) * D + h * 32 + ch * 8;
                                const u32x4 ka = *(const u32x4*)(Kb + go), kb2 = *(const u32x4*)(Kb + go + D), va = *(const u32x4*)(Vb + go), vb = *(const u32x4*)(Vb + go + D);
                                *(LAS u32x4*)(lds + tok * 64 + ((ch ^ ((tok >> 2) & 3)) * 16)) = ka;
                                *(LAS u32x4*)(lds + (tok + 1) * 64 + ((ch ^ (((tok + 1) >> 2) & 3)) * 16)) = kb2;
                                LAS unsigned* vt = (LAS unsigned*)(lds + VT_OFF + (ch * 8) * VT_STRIDE + tok * 2); constexpr int VS = VT_STRIDE / 4;
                                vt[0 * VS] = (va.x & 0xffffu) | (vb.x << 16); vt[1 * VS] = (va.x >> 16) | (vb.x & 0xffff0000u); vt[2 * VS] = (va.y & 0xffffu) | (vb.y << 16); vt[3 * VS] = (va.y >> 16) | (vb.y & 0xffff0000u);
                                vt[4 * VS] = (va.z & 0xffffu) | (vb.z << 16); vt[5 * VS] = (va.z >> 16) | (vb.z & 0xffff0000u); vt[6 * VS] = (va.w & 0xffffu) | (vb.w << 16); vt[7 * VS] = (va.w >> 16) | (vb.w & 0xffff0000u); } }
                        if (tq < 529) ((LAS float*)(lds + BI_OFF))[tq] = (tq >= 32 && tq < 497) ? rpbj[h * 465 + tq - 32] : 0.f;
                        asm volatile("s_waitcnt vmcnt(0) lgkmcnt(0)" ::: "memory");
                        __syncthreads();
#pragma unroll 1
                        for (int jb = 0; jb < 4; ++jb) {
                            const int c = 16 * jb + q, cs = min(max(c - 8, 0), GRID_W - 16), kc0 = min(max(16 * jb - 8, 0), 32);
                            const int swz = (((kc0 >> 2) + (q >> 2)) & 3);
                            const bf16x8 qv = jb == 0 ? qf[0] : (jb == 1 ? qf[1] : (jb == 2 ? qf[2] : qf[3]));
                            f32x4 s[8][2];
#pragma unroll
                            for (int i = 0; i < 8; ++i)
#pragma unroll
                                for (int cb = 0; cb < 2; ++cb) { const int tokk = (krb + i) * 64 + kc0 + 16 * cb + q;
                                    const bf16x8 kf = *(const LAS bf16x8*)(lds + tokk * 64 + ((g ^ swz) * 16));
                                    s[i][cb] = __builtin_amdgcn_mfma_f32_16x16x32_bf16(kf, qv, (f32x4){0.f, 0.f, 0.f, 0.f}, 0, 0, 0); }
                            const int t = cs - kc0; bool sl[4]; const LAS float* blr[4];
                            const LAS float* bl = (const LAS float*)(lds + BI_OFF) + (32 + drb * 31 + kc0 + 4 * g - c + 15);
#pragma unroll
                            for (int rg = 0; rg < 4; ++rg) { sl[rg] = (4 * g + rg) >= t; blr[rg] = bl + (sl[rg] ? rg : 16 + rg); }
                            const unsigned m01 = (sl[0] ? 0xffffu : 0u) | (sl[1] ? 0xffff0000u : 0u), m23 = (sl[2] ? 0xffffu : 0u) | (sl[3] ? 0xffff0000u : 0u);
                            float mx = -1e30f;
#pragma unroll
                            for (int i = 0; i < 8; ++i)
#pragma unroll
                                for (int rg = 0; rg < 4; ++rg) { const float v = (sl[rg] ? s[i][0][rg] : s[i][1][rg]) + blr[rg][31 * i]; s[i][0][rg] = v; mx = fmaxf(mx, v); }
                            mx = fmaxf(mx, __shfl_xor(mx, 16)); mx = fmaxf(mx, __shfl_xor(mx, 32));
                            float sum = 0.f; bf16x8 pb[8];
#pragma unroll
                            for (int i = 0; i < 8; ++i) { float p[4];
#pragma unroll
                                for (int rg = 0; rg < 4; ++rg) { p[rg] = __builtin_amdgcn_exp2f(s[i][0][rg] - mx); sum += p[rg]; }
                                const unsigned p01 = cvt_pk_bf16(p[0], p[1]), p23 = cvt_pk_bf16(p[2], p[3]);
                                u32x4 w; w.x = p01 & m01; w.y = p23 & m23; w.z = p01 & ~m01; w.w = p23 & ~m23;
                                pb[i] = __builtin_bit_cast(bf16x8, w); }
                            sum += __shfl_xor(sum, 16); sum += __shfl_xor(sum, 32);
                            f32x4 o0 = {0.f, 0.f, 0.f, 0.f}, o1 = {0.f, 0.f, 0.f, 0.f};
#pragma unroll
                            for (int i = 0; i < 8; ++i) { const LAS unsigned char* vb = lds + VT_OFF + q * VT_STRIDE + ((krb + i) * 64 + kc0 + 4 * g) * 2;
                                const u32x2 a0 = *(const LAS u32x2*)(vb), a1 = *(const LAS u32x2*)(vb + 32), c0 = *(const LAS u32x2*)(vb + 16 * VT_STRIDE), c1 = *(const LAS u32x2*)(vb + 16 * VT_STRIDE + 32);
                                const bf16x8 va = __builtin_bit_cast(bf16x8, (u32x4){a0.x, a0.y, a1.x, a1.y}), vc = __builtin_bit_cast(bf16x8, (u32x4){c0.x, c0.y, c1.x, c1.y});
                                o0 = __builtin_amdgcn_mfma_f32_16x16x32_bf16(va, pb[i], o0, 0, 0, 0); o1 = __builtin_amdgcn_mfma_f32_16x16x32_bf16(vc, pb[i], o1, 0, 0, 0); }
                            const float inv = 1.0f / sum; bf16_t* op = Ob + ((size_t)(b << 14) + r * 64 + c) * D + h * 32 + 4 * g;
                            u32x2 w0v, w1v; w0v.x = cvt_pk_bf16(o0[0] * inv, o0[1] * inv); w0v.y = cvt_pk_bf16(o0[2] * inv, o0[3] * inv); w1v.x = cvt_pk_bf16(o1[0] * inv, o1[1] * inv); w1v.y = cvt_pk_bf16(o1[2] * inv, o1[3] * inv);
                            *(u32x2*)op = w0v; *(u32x2*)(op + 16) = w1v;
                        }
                    }
                    PH_END;
                }
                ++pc;
                if (PH_ON && EN(7)) {

                    EpiResid E{XB, STAT(ST_F2 + layer), false, STAT(ST_F2 + layer), nullptr, nullptr};
                    pg8::gemm_phase<EpiResid, pg8::Shape<D, D, D, D, 0, 0, 4>>(lds, Ob, Wb + EL_NA0 + jm * EL_NA + EL_QKV, G, bx, E);
                    PH_END;
                }
                ++pc;
            } else if (kind == 1) {
                bf16_t* U = BIG; bf16_t* V = BIG + (size_t)M * DSGU;
                if (PH_ON && EN(8)) {

                    EpiSguIn E{U, V, STAT(ST_MIX + layer), STAT(ST_V)};
                    pg8::gemm_phase<EpiSguIn, pg8::Shape<SGU_IN, D, D, D, 0, 0, 8, 1>>(lds, XB, Wb + EL_SGU, G, bx, E);
                    PH_END;
                }
                ++pc;

                if (PH_ON && EN(3)) {
                    constexpr int LSTR = 272, VN_OFF = 128 * LSTR;
                    static_assert(VN_OFF + 256 * LSTR <= RING_BYTES, "SGU LDS");
                    int tq_ = threadIdx.x; asm volatile("" : "+v"(tq_));
                    const int tq = tq_, l = tq & 63, q = l & 15, g = l >> 4;
                    const u64* ssv = STAT(ST_V);
                    const int gq = bx & 15;
                    if ((G & 15) == 0) {
                        const bf16_t* wsrc = Wb + EL_SGU + EL_SIN + EL_SOUT + (size_t)gq * CHUNK * CHUNK;
#pragma unroll
                        for (int e = 0; e < 4; ++e) { const int id = tq + 512 * e, i = id >> 4, cj = id & 15; *(LAS u32x4*)(lds + i * LSTR + cj * 16) = *(const u32x4*)(wsrc + i * CHUNK + cj * 8); }
                    }
                    for (int un = bx; un < (M / CHUNK) * SGG; un += G) {
                        const int n = un >> 4;
                        __syncthreads();
                        if ((G & 15) != 0) {
                            const bf16_t* wsrc = Wb + EL_SGU + EL_SIN + EL_SOUT + (size_t)(un & 15) * CHUNK * CHUNK;
#pragma unroll
                            for (int e = 0; e < 4; ++e) { const int id = tq + 512 * e, i = id >> 4, cj = id & 15; *(LAS u32x4*)(lds + i * LSTR + cj * 16) = *(const u32x4*)(wsrc + i * CHUNK + cj * 8); }
                        }
                        const int gu = un & 15;
#pragma unroll
                        for (int e = 0; e < 4; ++e) { const int id = tq + 512 * e, j = (id & 63) * 2, cc = id >> 6; const int tok = n * CHUNK + j;
                            const u32x4 va = *(const u32x4*)(V + (size_t)tok * DSGU + gu * SGD + cc * 8), vb = *(const u32x4*)(V + (size_t)(tok + 1) * DSGU + gu * SGD + cc * 8);
                            const float ra = rsq(stat_get(ssv, tok) * (1.0f / DSGU) + EPS), rb = rsq(stat_get(ssv, tok + 1) * (1.0f / DSGU) + EPS);
                            LAS unsigned* vt = (LAS unsigned*)(lds + VN_OFF + (cc * 8) * LSTR + j * 2); constexpr int VS = LSTR / 4;
#define B2_PAIR(dd, W) do { vt[(2 * dd) * VS] = cvt_pk_bf16(bflo(va.W) * ra, bflo(vb.W) * rb); vt[(2 * dd + 1) * VS] = cvt_pk_bf16(bfhi(va.W) * ra, bfhi(vb.W) * rb); } while (0)
                            B2_PAIR(0, x); B2_PAIR(1, y); B2_PAIR(2, z); B2_PAIR(3, w);
#undef B2_PAIR
                        }
                        asm volatile("s_waitcnt vmcnt(0) lgkmcnt(0)" ::: "memory");
                        __syncthreads();
                        f32x4 acc[2][8];
#pragma unroll
                        for (int ct = 0; ct < 2; ++ct)
#pragma unroll
                            for (int it = 0; it < 8; ++it) acc[ct][it] = (f32x4){0.f, 0.f, 0.f, 0.f};
#pragma unroll
                        for (int ks = 0; ks < 4; ++ks) {
                            const bf16x8 a0 = *(const LAS bf16x8*)(lds + VN_OFF + (32 * wave + q) * LSTR + (ks * 32 + 8 * g) * 2), a1 = *(const LAS bf16x8*)(lds + VN_OFF + (32 * wave + 16 + q) * LSTR + (ks * 32 + 8 * g) * 2);
#pragma unroll
                            for (int it = 0; it < 8; ++it) { const bf16x8 wf = *(const LAS bf16x8*)(lds + (16 * it + q) * LSTR + (ks * 32 + 8 * g) * 2);
                                acc[0][it] = __builtin_amdgcn_mfma_f32_16x16x32_bf16(a0, wf, acc[0][it], 0, 0, 0); acc[1][it] = __builtin_amdgcn_mfma_f32_16x16x32_bf16(a1, wf, acc[1][it], 0, 0, 0); }
                        }
#pragma unroll
                        for (int ct = 0; ct < 2; ++ct) { const int chb = gu * SGD + 32 * wave + 16 * ct + 4 * g; const f32x4 gn = *(const f32x4*)(par + PAR_VG + chb);
#pragma unroll
                            for (int it = 0; it < 8; ++it) { const int i = 16 * it + q; const float bs = par[PAR_BS + gu * CHUNK + i];
                                bf16_t* up = U + (size_t)(n * CHUNK + i) * DSGU + chb; const u32x2 uw = *(const u32x2*)up; const f32x4 a = acc[ct][it];
                                u32x2 w; w.x = cvt_pk_bf16(bflo(uw.x) * (gn[0] * a[0] + bs), bfhi(uw.x) * (gn[1] * a[1] + bs)); w.y = cvt_pk_bf16(bflo(uw.y) * (gn[2] * a[2] + bs), bfhi(uw.y) * (gn[3] * a[3] + bs));
                                *(u32x2*)up = w; } }
                    }
                    PH_END;
                }
                ++pc;
                if (PH_ON && EN(9)) {

                    EpiResid E{XB, STAT(ST_F2 + layer), false, STAT(ST_F2 + layer), nullptr, nullptr};
                    pg8::gemm_phase<EpiResid, pg8::Shape<D, DSGU, DSGU, DSGU, 0, 0, 4>>(lds, U, Wb + EL_SGU + EL_SIN, G, bx, E);
                    PH_END;
                }
                ++pc;
            } else {
                bf16_t* P = BIG;
                if (PH_ON && EN(4)) {
                    const u64* ssm = STAT(ST_MIX + layer);
                    const int gi = lane >> 4, hw = 1 << gi;
#define POOL_ROW(ROWT, WGT, OP) do { const int sx_ = (ROWT); const bool in_ = (sx_ >= 0) && (sx_ < SEQ) && (WGT); const int row_ = (b << 14) + min(max(sx_, 0), SEQ - 1); \
        const float rs_ = in_ ? rsq(stat_get(ssm, row_) * (1.0f / D) + EPS) : 0.f; const u32x4* xp_ = (const u32x4*)(XB + xb_off(row_, lane * 32)); \
        _Pragma("unroll") for (int e = 0; e < 4; ++e) { const u32x4 w_ = xp_[e]; \
            sum[8 * e + 0] OP bflo(w_.x) * rs_; sum[8 * e + 1] OP bfhi(w_.x) * rs_; sum[8 * e + 2] OP bflo(w_.y) * rs_; sum[8 * e + 3] OP bfhi(w_.y) * rs_; \
            sum[8 * e + 4] OP bflo(w_.z) * rs_; sum[8 * e + 5] OP bfhi(w_.z) * rs_; sum[8 * e + 6] OP bflo(w_.w) * rs_; sum[8 * e + 7] OP bfhi(w_.w) * rs_; } } while (0)
                    for (int run = gw; run < M / 16; run += NGW) {
                        const int t0 = run * 16, b = t0 >> 14, tt0 = t0 & 16383;
                        float sum[32];
#pragma unroll
                        for (int e = 0; e < 32; ++e) sum[e] = 0.f;
#pragma unroll 4
                        for (int off = -8; off < 8; ++off) POOL_ROW(tt0 + off, (off >= -hw) && (off < hw), +=);
#pragma unroll 2
                        for (int k = 0; k < 16; ++k) {
                            const int tt = tt0 + k, t = t0 + k;
                            const float ic = 1.0f / (float)(min(tt + hw, SEQ) - max(tt - hw, 0)), rst = rsq(stat_get(ssm, t) * (1.0f / D) + EPS);
                            const u32x4* xs = (const u32x4*)(XB + xb_off(t, lane * 32)); u32x4* pp = (u32x4*)(P + (size_t)t * D + lane * 32);
#pragma unroll
                            for (int e = 0; e < 4; ++e) { const u32x4 x = xs[e]; u32x4 w;
                                w.x = cvt_pk_bf16(sum[8 * e + 0] * ic - bflo(x.x) * rst, sum[8 * e + 1] * ic - bfhi(x.x) * rst); w.y = cvt_pk_bf16(sum[8 * e + 2] * ic - bflo(x.y) * rst, sum[8 * e + 3] * ic - bfhi(x.y) * rst);
                                w.z = cvt_pk_bf16(sum[8 * e + 4] * ic - bflo(x.z) * rst, sum[8 * e + 5] * ic - bfhi(x.z) * rst); w.w = cvt_pk_bf16(sum[8 * e + 6] * ic - bflo(x.w) * rst, sum[8 * e + 7] * ic - bfhi(x.w) * rst); pp[e] = w; }
                            POOL_ROW(tt + hw, true, +=);
                            POOL_ROW(tt - hw, true, -=);
                        }
                    }
#undef POOL_ROW
                    PH_END;
                }
                ++pc;
                if (PH_ON && EN(10)) {

                    EpiResid E{XB, STAT(ST_F2 + layer), false, STAT(ST_F2 + layer), nullptr, nullptr};
                    pg8::gemm_phase<EpiResid, pg8::Shape<D, PGD, D, PGD, 2, PGD * 2>>(lds, P, Wb + EL_POOL, G, bx, E);
                    PH_END;
                }
                ++pc;
            }
        }
        bf16_t* H = BIG;
        const bf16_t* Wf = Wb + (size_t)step * EL_FFN;
        if (PH_ON && EN(11)) {

            EpiSwiGLU E{H, which ? STAT(ST_F2 + layer) : STAT(ST_F1 + layer), STAT(ST_S1 + layer), (which == 0 && layer > 0), -1, {}};
            pg8::gemm_phase<EpiSwiGLU, pg8::Shape<2 * DFF, D, D, D, 0, 0, 8, 1>>(lds, XB, Wf, G, bx, E);
            PH_END;
        }
        ++pc;

        if (PH_ON && EN(12)) {

            EpiResid E{XB, STAT(ST_S1 + layer), (which == 0 && layer > 0), which ? STAT(ST_F1 + layer + 1) : STAT(ST_MIX + layer),
                       which ? par + PAR_GOUT + layer * D : nullptr, which ? STAT(ST_S1 + layer + 1) : nullptr};
            pg8::gemm_phase<EpiResid, pg8::Shape<D, DFF, DFF, DFF, 0, 0, 4, 1>>(lds, H, Wf + EL_GU, G, bx, E);
            PH_END;
        }
        ++pc;
    }
    if (PH_ON && EN(5)) {
        const u64* s1 = STAT(ST_S1 + DEPTH);
        for (int m2 = gw; m2 < M / 2; m2 += NGW) { const int m = 2 * m2 + (lane >> 5), hl = lane & 31;
            const float ps = rsq(stat_get(s1, m) * (1.0f / D) + EPS); f32x4* xo = (f32x4*)(X + (size_t)m * D) + 2 * hl; const bf16_t* xb = XB + xb_off(m, 8 * hl);
#pragma unroll
            for (int j = 0; j < 8; ++j) { const u32x4 w = *(const u32x4*)(xb + (size_t)j * 8 * 512);
                xo[64 * j] = (f32x4){bflo(w.x), bfhi(w.x), bflo(w.y), bfhi(w.y)} * ps; xo[64 * j + 1] = (f32x4){bflo(w.z), bfhi(w.z), bflo(w.w), bfhi(w.w)} * ps; } }
    }
    ++pc;
}

constexpr int N_PHASES = 1 + DEPTH * 4 + 3 + 3 + 2 + 3 + 1;
#ifndef MK_PER_PHASE
#define MK_PER_PHASE 0
#endif

extern "C" void kernel_launch(void* const* d_in, const int* in_sizes, int n_in, void* d_out, int out_size, void* d_ws, size_t ws_size, hipStream_t stream) {
    static int grid = 0;
    if (grid == 0) {
        if (n_in != 23 || in_sizes[0] != M * D || out_size != M * D || ws_size < WS_END) { fprintf(stderr, "kernel_launch: unexpected problem (n_in %d, in0 %d, out %d, ws %zu < %zu)\n", n_in, n_in > 0 ? in_sizes[0] : -1, out_size, ws_size, (size_t)WS_END); grid = -1; return; }
        int dev = 0, cus = 0, per_cu = 0;
        if (hipGetDevice(&dev) != hipSuccess || hipDeviceGetAttribute(&cus, hipDeviceAttributeMultiprocessorCount, dev) != hipSuccess) { grid = -1; return; }
        if (hipFuncSetAttribute((const void*)mega_fwd, hipFuncAttributeMaxDynamicSharedMemorySize, LDS_BYTES) != hipSuccess) { fprintf(stderr, "kernel_launch: hipFuncSetAttribute failed\n"); grid = -1; return; }
        if (hipOccupancyMaxActiveBlocksPerMultiprocessor(&per_cu, (const void*)mega_fwd, 512, LDS_BYTES) != hipSuccess || per_cu < 1) fprintf(stderr, "kernel_launch: occupancy query says %d\n", per_cu);
        (void)hipGetLastError();
        grid = cus;
    }
    if (grid < 0) return;
    (void)hipMemsetAsync((char*)d_ws + WS_CTL, 0, CTL_ZERO_BYTES, stream);
    Args a{};
    for (int i = 0; i < 23; ++i) a.in[i] = (const float*)d_in[i];
    a.out = (float*)d_out; a.ws = (unsigned char*)d_ws;
#if MK_PER_PHASE
    for (int p = 0; p < N_PHASES; ++p) { a.ph_lo = p; a.ph_hi = p + 1; hipLaunchKernelGGL(mega_fwd, dim3(grid), dim3(512), LDS_BYTES, stream, a); }
#else
    a.ph_lo = 0; a.ph_hi = N_PHASES;
    hipLaunchKernelGGL(mega_fwd, dim3(grid), dim3(512), LDS_BYTES, stream, a);
#endif
}
```

```cpp
#include <hip/hip_runtime.h>
#include <cstdio>
#include <cstdint>

constexpr int D = 2048, SEQ = 16384, M = 32768, DEPTH = 4, DFF = 5632;
constexpr int NHEAD = 64, HD = 32, GRID_W = 64, GROWS = 256, NQKV = 3 * D;
constexpr int DSGU = 4096, SGU_IN = 8192, CHUNK = 128, SGG = 16, SGD = 256;
constexpr int PGD = 512;
constexpr float EPS = 1e-6f;
constexpr float LOG2E = 1.4426950408889634f;
constexpr float QSCALE = 0.17677669529663687f * LOG2E;

typedef unsigned short bf16_t;
#define LAS __attribute__((address_space(3)))
#define GAS __attribute__((address_space(1)))
typedef short bf16x8 __attribute__((ext_vector_type(8)));
typedef float f32x4 __attribute__((ext_vector_type(4)));
typedef float f32x2 __attribute__((ext_vector_type(2)));
typedef unsigned u32x4 __attribute__((ext_vector_type(4)));
typedef unsigned u32x2 __attribute__((ext_vector_type(2)));

__device__ __forceinline__ unsigned cvt_pk_bf16(float lo, float hi) { unsigned r; asm volatile("v_cvt_pk_bf16_f32 %0, %1, %2" : "=v"(r) : "v"(lo), "v"(hi)); return r; }
__device__ __forceinline__ float bflo(unsigned w) { return __uint_as_float(w << 16); }
__device__ __forceinline__ float bfhi(unsigned w) { return __uint_as_float(w & 0xffff0000u); }
__device__ __forceinline__ float bf2f(bf16_t b) { return __uint_as_float(((unsigned)b) << 16); }
__device__ __forceinline__ float rsq(float x) { return __builtin_amdgcn_rsqf(x); }
typedef unsigned long long u64;
constexpr float STAT_SCALE = 4194304.0f, STAT_INV = 1.0f / 4194304.0f;
__device__ __forceinline__ u64 stat_fix(float s) { return (u64)(long long)__float2ll_rn(s * STAT_SCALE); }
__device__ __forceinline__ float stat_f(u64 v) { return ((float)(unsigned)(v >> 32) * 4294967296.0f + (float)(unsigned)v) * STAT_INV; }
__device__ __forceinline__ float stat_get(const u64* p, int r) { return stat_f(p[r]); }
__device__ __forceinline__ void stat_add(u64* p, int r, float s) { atomicAdd(p + r, stat_fix(s)); }

#ifndef PG8_PRIO
#define PG8_PRIO 1
#endif
#ifndef PG8_SP2
#define PG8_SP2 1
#endif
namespace pg8 {
constexpr int BM = 256, BK = 64, HALF = 128, HTB = HALF * BK * 2, STAGE_BYTES = 8 * HTB, NXCD = 8, WGM = 8;
__host__ __device__ __forceinline__ int lds_byte(int r, int c) { const int st = (r >> 4) * 2 + (c >> 5), rr = r & 15, cc = c & 31, ob = rr * 64 + cc * 2; return st * 1024 + (ob ^ (((ob >> 9) & 1) << 5)); }
__host__ __device__ __forceinline__ void stage_rc(int b, int& R, int& C) { const int st = b / 1024, sb = b % 1024, swz = sb ^ (((sb >> 9) & 1) << 5); R = (st >> 1) * 16 + swz / 64; C = (st & 1) * 32 + (swz % 64) / 2; }
__host__ __device__ __forceinline__ int perm32(int rho) { const int n = rho >> 4, i = rho & 15; return 8 * (i >> 2) + 4 * n + (i & 3); }

struct Unit { int pm, pn; };
template <int N_, int K_, int LDA_, int LDB_, int GT_ = 0, int GAB_ = 0, int WGM_ = 8, int ATILE_ = 0> struct Shape { static constexpr int N = N_, K = K_, LDA = LDA_, LDB = LDB_, GT = GT_, GAB = GAB_, WGMS = WGM_, ATILE = ATILE_; };

template <int nM, int nN, int WGMS> struct StaticOrder {
    int G, c;
    __device__ __forceinline__ bool next(int i, Unit& u) const {
        constexpr int nwg = nM * nN;
        const int L = i * G + c; if (L >= nwg) return false;
        int wgid = L; { constexpr int q = nwg / NXCD, r = nwg % NXCD; const int xcd = wgid % NXCD, off = wgid / NXCD; wgid = (xcd < r ? xcd * (q + 1) : r * (q + 1) + (xcd - r) * q) + off; }
        constexpr int nig = WGMS * nN; const int gid = wgid / nig, fm = gid * WGMS, gsz = (nM - fm) < WGMS ? (nM - fm) : WGMS;
        u.pm = fm + ((wgid % nig) % gsz); u.pn = (wgid % nig) / gsz; return true;
    }
};

template <class Epi, class SH>
__device__ __forceinline__ void gemm_phase(LAS unsigned char* lds, const bf16_t* gA, const bf16_t* gBt, int G_, int c_, Epi& E) {
    StaticOrder<32768 / BM, SH::N / BM, SH::WGMS> S; S.G = G_; S.c = c_;
    int tid_ = threadIdx.x; asm volatile("" : "+v"(tid_));
    const int tid = tid_, wid = __builtin_amdgcn_readfirstlane(tid >> 6), lane = tid & 63, wr = wid >> 2, wc = wid & 3, fr = lane & 15, fq = lane >> 4;
    constexpr int nt = SH::K / BK;
    unsigned voffA[2], voffB[2];
#pragma unroll
    for (int i = 0; i < 2; ++i) { int R, C; stage_rc(tid * 16 + i * 8192, R, C); const int Rb = Epi::PERM ? ((R & ~31) + perm32(R & 31)) : R;
        voffA[i] = SH::ATILE ? (unsigned)(((R >> 4) * (SH::LDA / 32) + (C >> 5)) * 1024 + (R & 15) * 64 + (C & 31) * 2) : (unsigned)(R * SH::LDA + C) * 2u;
        static_assert(Epi::PERM, "the weight copies are stored pre-permuted"); (void)Rb;
        voffB[i] = (unsigned)(((R >> 4) * (SH::LDB / 32) + (C >> 5)) * 1024 + (R & 15) * 64 + (C & 31) * 2); }
    const unsigned kstep = 2048u, kstepA = SH::ATILE ? 2048u : (unsigned)(BK * 2);
    constexpr unsigned hA = (unsigned)HALF * SH::LDA * 2, hB = (unsigned)HALF * SH::LDB * 2, tA = 2 * hA, tB = 2 * hB;
    const __amdgpu_buffer_rsrc_t rsA = __builtin_amdgcn_make_buffer_rsrc((void*)gA, 0, -1, 0x00020000), rsB = __builtin_amdgcn_make_buffer_rsrc((void*)gBt, 0, -1, 0x00020000);
    const unsigned ldsw = (unsigned)wid * 1024u;
    const int aoff = lds_byte(wr * 64 + fr, fq * 8), boff = lds_byte(wc * 32 + fr, fq * 8);
#define PG8_APTR(u) ((unsigned)(u).pm * tA + (SH::GT ? (unsigned)((u).pn / (SH::GT ? SH::GT : 1)) * (unsigned)SH::GAB : 0u))
#define PG8_BPTR(u) ((unsigned)(u).pn * tB)
#define PG8_RS_voffA rsA
#define PG8_RS_voffB rsB
#define PG8_SA(b, h) (((b) * 2 + (h)) * HTB)
#define PG8_SB(b, h) ((4 + (b) * 2 + (h)) * HTB)
#define PG8_STAGE(bufoff, gbase, voff) do { _Pragma("unroll") for (int _i = 0; _i < 2; ++_i) \
        __builtin_amdgcn_raw_ptr_buffer_load_lds(PG8_RS_##voff, (LAS unsigned*)(lds + (bufoff) + ldsw + _i * 8192), 16, (int)(voff)[_i], (int)(gbase), 0, 0); } while (0)
#define PG8_LDA(dst, b, h) do { _Pragma("unroll") for (int m = 0; m < 4; ++m) _Pragma("unroll") for (int k = 0; k < 2; ++k) dst[m][k] = *(const LAS bf16x8*)(lds + PG8_SA(b, h) + aoff + m * 2048 + k * 1024); } while (0)
#define PG8_LDB(dst, b, h) do { _Pragma("unroll") for (int n = 0; n < 2; ++n) _Pragma("unroll") for (int k = 0; k < 2; ++k) dst[n][k] = *(const LAS bf16x8*)(lds + PG8_SB(b, h) + boff + n * 2048 + k * 1024); } while (0)
#define PG8_MMA(ai, bj, At, Bt) do { if (PG8_PRIO) __builtin_amdgcn_s_setprio(1); _Pragma("unroll") for (int m = 0; m < 4; ++m) _Pragma("unroll") for (int n = 0; n < 2; ++n) _Pragma("unroll") for (int k = 0; k < 2; ++k) \
        acc[ai][bj][m][n] = __builtin_amdgcn_mfma_f32_16x16x32_bf16(Bt[n][k], At[m][k], acc[ai][bj][m][n], 0, 0, 0); if (PG8_PRIO) __builtin_amdgcn_s_setprio(0); } while (0)
#define PG8_WAIT_V(n) asm volatile("s_waitcnt vmcnt(" #n ")" ::: "memory")
#define PG8_WAIT_L(n) asm volatile("s_waitcnt lgkmcnt(" #n ")" ::: "memory")
#define PG8_BAR __builtin_amdgcn_s_barrier()
#define PG8_SCHED __builtin_amdgcn_sched_barrier(0)
    Unit cur, nxt; int ui = 0;
    if (!S.next(0, cur)) return;
    f32x4 acc[2][2][4][2];
#pragma unroll
    for (int a = 0; a < 2; ++a)
#pragma unroll
        for (int b = 0; b < 2; ++b)
#pragma unroll
            for (int m = 0; m < 4; ++m)
#pragma unroll
                for (int n = 0; n < 2; ++n) acc[a][b][m][n] = (f32x4){0.f, 0.f, 0.f, 0.f};
    bf16x8 At[4][2], B0[2][2], B1[2][2];
    unsigned cA = PG8_APTR(cur), cB = PG8_BPTR(cur);
#if PG8_SP2
    PG8_STAGE(PG8_SB(0, 0), cB, voffB); PG8_STAGE(PG8_SB(0, 1), cB + hB, voffB); PG8_STAGE(PG8_SA(0, 0), cA, voffA); PG8_STAGE(PG8_SA(0, 1), cA + hA, voffA);
    if (wr == 1) PG8_BAR;
    PG8_WAIT_V(2); PG8_BAR;
    PG8_STAGE(PG8_SB(1, 0), cB + kstep, voffB); PG8_STAGE(PG8_SA(1, 0), cA + kstepA, voffA); PG8_STAGE(PG8_SB(1, 1), cB + hB + kstep, voffB);
    PG8_WAIT_V(6); PG8_BAR;
#else
    PG8_STAGE(PG8_SB(0, 0), cB, voffB); PG8_STAGE(PG8_SA(0, 0), cA, voffA); PG8_STAGE(PG8_SB(0, 1), cB + hB, voffB); PG8_STAGE(PG8_SA(0, 1), cA + hA, voffA);
    if (wr == 1) PG8_BAR;
    PG8_WAIT_V(4); PG8_BAR;
    PG8_STAGE(PG8_SB(1, 0), cB + kstep, voffB); PG8_STAGE(PG8_SA(1, 0), cA + kstepA, voffA); PG8_STAGE(PG8_SB(1, 1), cB + hB + kstep, voffB);
    PG8_WAIT_V(6); PG8_BAR;
#endif
    for (;;) {
        const bool has_next = S.next(ui + 1, nxt);
        const unsigned nA = has_next ? PG8_APTR(nxt) : cA, nB = has_next ? PG8_BPTR(nxt) : cB;
        for (int t = 0; t < nt; t += 2) {
            const bool last = (t == nt - 2);
            const unsigned a1 = cA + (unsigned)(t + 1) * kstepA;
            const unsigned a2 = last ? nA : cA + (unsigned)(t + 2) * kstepA, b2 = last ? nB : cB + (unsigned)(t + 2) * kstep;
            const unsigned a3 = a2 + kstepA, b3 = b2 + kstep;
#if PG8_SP2
            PG8_LDB(B0, 0, 0); PG8_LDB(B1, 0, 1); PG8_SCHED; PG8_LDA(At, 0, 0); PG8_STAGE(PG8_SA(1, 1), a1 + hA, voffA);
            PG8_WAIT_V(8); PG8_WAIT_L(0); PG8_BAR; PG8_MMA(0, 0, At, B0); PG8_MMA(0, 1, At, B1); PG8_BAR; PG8_SCHED;
            PG8_LDA(At, 0, 1); PG8_STAGE(PG8_SB(0, 0), b2, voffB); PG8_STAGE(PG8_SB(0, 1), b2 + hB, voffB); PG8_STAGE(PG8_SA(0, 0), a2, voffA);
            PG8_WAIT_V(8); PG8_WAIT_L(0); PG8_BAR; PG8_MMA(1, 0, At, B0); PG8_MMA(1, 1, At, B1); PG8_BAR; PG8_SCHED;
            PG8_LDB(B0, 1, 0); PG8_LDB(B1, 1, 1); PG8_SCHED; PG8_LDA(At, 1, 0); PG8_STAGE(PG8_SA(0, 1), a2 + hA, voffA);
            PG8_WAIT_V(8); PG8_WAIT_L(0); PG8_BAR; PG8_MMA(0, 0, At, B0); PG8_MMA(0, 1, At, B1); PG8_BAR; PG8_SCHED;
            PG8_LDA(At, 1, 1); PG8_STAGE(PG8_SB(1, 0), b3, voffB); PG8_STAGE(PG8_SB(1, 1), b3 + hB, voffB); PG8_STAGE(PG8_SA(1, 0), a3, voffA);
            PG8_WAIT_V(8); PG8_WAIT_L(0); PG8_BAR; PG8_MMA(1, 0, At, B0); PG8_MMA(1, 1, At, B1); PG8_BAR; PG8_SCHED;
#else
            PG8_LDB(B0, 0, 0); PG8_SCHED; PG8_LDA(At, 0, 0); PG8_STAGE(PG8_SA(1, 1), a1 + hA, voffA);
            PG8_WAIT_L(8); PG8_BAR; PG8_WAIT_L(0); PG8_MMA(0, 0, At, B0); PG8_BAR; PG8_SCHED;
            PG8_LDB(B1, 0, 1); PG8_STAGE(PG8_SB(0, 0), b2, voffB);
            PG8_BAR; PG8_WAIT_L(0); PG8_MMA(0, 1, At, B1); PG8_BAR;
            PG8_LDA(At, 0, 1); PG8_STAGE(PG8_SA(0, 0), a2, voffA);
            PG8_BAR; PG8_WAIT_L(0); PG8_MMA(1, 0, At, B0); PG8_BAR; PG8_SCHED;
            PG8_STAGE(PG8_SB(0, 1), b2 + hB, voffB);
            PG8_WAIT_V(6); PG8_BAR; PG8_MMA(1, 1, At, B1); PG8_BAR;
            PG8_LDB(B0, 1, 0); PG8_SCHED; PG8_LDA(At, 1, 0); PG8_STAGE(PG8_SA(0, 1), a2 + hA, voffA);
            PG8_WAIT_L(8); PG8_BAR; PG8_WAIT_L(0); PG8_MMA(0, 0, At, B0); PG8_BAR; PG8_SCHED;
            PG8_LDB(B1, 1, 1); PG8_STAGE(PG8_SB(1, 0), b3, voffB);
            PG8_BAR; PG8_WAIT_L(0); PG8_MMA(0, 1, At, B1); PG8_BAR;
            PG8_LDA(At, 1, 1); PG8_STAGE(PG8_SA(1, 0), a3, voffA);
            PG8_BAR; PG8_WAIT_L(0); PG8_MMA(1, 0, At, B0); PG8_BAR; PG8_SCHED;
            PG8_STAGE(PG8_SB(1, 1), b3 + hB, voffB);
            PG8_WAIT_V(6); PG8_BAR; PG8_MMA(1, 1, At, B1); PG8_BAR;
#endif
        }
        if (wr == 0) PG8_BAR;
        E(acc, cur, wr, wc, fr, fq);
        if (!has_next) break;
        if (!Epi::ZEROES)
#pragma unroll
        for (int a = 0; a < 2; ++a)
#pragma unroll
            for (int b = 0; b < 2; ++b)
#pragma unroll
                for (int m = 0; m < 4; ++m)
#pragma unroll
                    for (int n = 0; n < 2; ++n) { double z0, z1; asm volatile("v_mov_b64 %0, 0" : "=v"(z0)); asm volatile("v_mov_b64 %0, 0" : "=v"(z1));
                        const f32x2 l = __builtin_bit_cast(f32x2, z0), h = __builtin_bit_cast(f32x2, z1); acc[a][b][m][n] = (f32x4){l.x, l.y, h.x, h.y}; }
        cur = nxt; cA = nA; cB = nB; ++ui;
        if (wr == 1) PG8_BAR;
    }
    PG8_WAIT_V(0);
    PG8_BAR;
#undef PG8_APTR
#undef PG8_BPTR
#undef PG8_RS_voffA
#undef PG8_RS_voffB
#undef PG8_SA
#undef PG8_SB
#undef PG8_STAGE
#undef PG8_LDA
#undef PG8_LDB
#undef PG8_MMA
#undef PG8_WAIT_V
#undef PG8_WAIT_L
#undef PG8_BAR
#undef PG8_SCHED
}
}

__device__ __forceinline__ f32x2 gelu_pk(f32x2 v) {
    const f32x2 av = __builtin_elementwise_abs(v), d = av * 0.2316418882f + 1.0f;
    f32x2 t; t.x = __builtin_amdgcn_rcpf(d.x); t.y = __builtin_amdgcn_rcpf(d.y);
    f32x2 q = t * 0.5307027145f + (-0.7265760135f); q = q * t + 0.7107068705f; q = q * t + (-0.142248368f); q = q * t + 0.127414796f; q = q * t;
    const f32x2 s = (v * v) * (-0.72134752044f);
    f32x2 e; e.x = __builtin_amdgcn_exp2f(s.x); e.y = __builtin_amdgcn_exp2f(s.y);
    const f32x2 m = v * (q * e), r = v - m;
    f32x2 o; o.x = v.x < 0.f ? m.x : r.x; o.y = v.y < 0.f ? m.y : r.y; return o;
}
__device__ __forceinline__ float silu_f(float x) { return x * __builtin_amdgcn_rcpf(1.0f + __builtin_amdgcn_exp2f(-LOG2E * x)); }

__device__ __forceinline__ float row_ps(const u64* s1, bool has1, int r) { const float p = rsq(stat_f(s1[r]) * (1.0f / D) + EPS); return has1 ? p : 1.0f; }
__device__ __forceinline__ float row_cf(const u64* ss, const u64* s1, bool has1, int r) { const float ps = row_ps(s1, has1, r); return ps * rsq(ps * ps * stat_f(ss[r]) * (1.0f / D) + EPS); }

struct EpiSwiGLU {
    static constexpr bool PERM = true, ZEROES = true;
    bf16_t* O; const u64* ss; const u64* s1; bool has1; int cf_pm; float cfv[2][4];
    __device__ __forceinline__ void operator()(f32x4 (&acc)[2][2][4][2], const pg8::Unit& u, int wr, int wc, int fr, int fq) {
        const int row0 = u.pm * 256 + wr * 64 + fr;
        if (u.pm != cf_pm) { cf_pm = u.pm;
#pragma unroll
        for (int ai = 0; ai < 2; ++ai)
#pragma unroll
            for (int m = 0; m < 4; ++m) cfv[ai][m] = row_cf(ss, s1, has1, row0 + ai * 128 + m * 16); }
        char* const obase = (char*)O + ((size_t)(u.pm * 16 + wr * 4) * (DFF / 32) + u.pn * 4 + wc) * 1024 + fr * 64 + fq * 16;
#pragma unroll
        for (int ai = 0; ai < 2; ++ai)
#pragma unroll
            for (int m = 0; m < 4; ++m) { const float cf = cfv[ai][m], c1 = -LOG2E * cf, ic2 = __builtin_amdgcn_rcpf(cf * cf);
                u32x4 w;
#pragma unroll
                for (int n = 0; n < 2; ++n) { const f32x4 g = acc[ai][0][m][n], uu = acc[ai][1][m][n];
                    const f32x2 ga = {g[0], g[1]}, gb = {g[2], g[3]}, ua = {uu[0], uu[1]}, ub = {uu[2], uu[3]};
                    const f32x2 ta = ga * c1, tb = gb * c1; f32x2 ea, eb; ea.x = __builtin_amdgcn_exp2f(fminf(ta.x, 40.f)); ea.y = __builtin_amdgcn_exp2f(fminf(ta.y, 40.f)); eb.x = __builtin_amdgcn_exp2f(fminf(tb.x, 40.f)); eb.y = __builtin_amdgcn_exp2f(fminf(tb.y, 40.f));
                    const f32x2 da = ea * ic2 + ic2, db = eb * ic2 + ic2, pp = da * db; f32x2 rr; rr.x = __builtin_amdgcn_rcpf(pp.x); rr.y = __builtin_amdgcn_rcpf(pp.y);
                    const f32x2 oa = (ga * ua) * (rr * db), ob = (gb * ub) * (rr * da);
                    if (n == 0) { w.x = cvt_pk_bf16(oa.x, oa.y); w.y = cvt_pk_bf16(ob.x, ob.y); } else { w.z = cvt_pk_bf16(oa.x, oa.y); w.w = cvt_pk_bf16(ob.x, ob.y); } }
                __builtin_nontemporal_store(w, (u32x4*)(obase + (size_t)(ai * 8 + m) * (DFF / 32) * 1024));
#pragma unroll
                for (int bj = 0; bj < 2; ++bj)
#pragma unroll
                    for (int n = 0; n < 2; ++n) { double z0, z1; asm volatile("v_mov_b64 %0, 0" : "=v"(z0)); asm volatile("v_mov_b64 %0, 0" : "=v"(z1));
                        const f32x2 l = __builtin_bit_cast(f32x2, z0), h = __builtin_bit_cast(f32x2, z1); acc[ai][bj][m][n] = (f32x4){l.x, l.y, h.x, h.y}; } }
    }
};
__device__ __forceinline__ size_t xb_off(int r, int c) { return ((size_t)(r >> 4) * (D / 32) + (c >> 5)) * 512 + (r & 15) * 32 + (c & 31); }
struct EpiResid {
    static constexpr bool PERM = true, ZEROES = false;
    bf16_t* XB; const u64* s1_in; bool has1; u64* ss_out; const float* gout; u64* s1_out;
    __device__ __forceinline__ void operator()(const f32x4 (&acc)[2][2][4][2], const pg8::Unit& u, int wr, int wc, int fr, int fq) {
        const int row0 = u.pm * 256 + wr * 64 + fr, col0 = u.pn * 256 + wc * 32 + 8 * fq;
        float psv[2][4];
#pragma unroll
        for (int ai = 0; ai < 2; ++ai)
#pragma unroll
            for (int m = 0; m < 4; ++m) psv[ai][m] = row_ps(s1_in, has1, row0 + ai * 128 + m * 16);
#define RESID_ROW(ai, m, XROW) do { const int r = row0 + ai * 128 + m * 16; const float ps = psv[ai][m]; float sA = 0.f, sB = 0.f; \
_Pragma("unroll") \
                for (int bj = 0; bj < 2; ++bj) { const u32x4 xw = XROW[bj]; \
                    f32x4 v0 = (f32x4){bflo(xw.x), bfhi(xw.x), bflo(xw.y), bfhi(xw.y)} * ps + acc[ai][bj][m][0], v1 = (f32x4){bflo(xw.z), bfhi(xw.z), bflo(xw.w), bfhi(xw.w)} * ps + acc[ai][bj][m][1]; \
                    if (gout) { sB += (v0[0] * v0[0] + v0[1] * v0[1]) + (v0[2] * v0[2] + v0[3] * v0[3]) + (v1[0] * v1[0] + v1[1] * v1[1]) + (v1[2] * v1[2] + v1[3] * v1[3]); \
                        v0 = v0 * *(const f32x4*)(gout + col0 + bj * 128); v1 = v1 * *(const f32x4*)(gout + col0 + bj * 128 + 4); } \
                    sA += (v0[0] * v0[0] + v0[1] * v0[1]) + (v0[2] * v0[2] + v0[3] * v0[3]) + (v1[0] * v1[0] + v1[1] * v1[1]) + (v1[2] * v1[2] + v1[3] * v1[3]); \
                    u32x4 w; w.x = cvt_pk_bf16(v0[0], v0[1]); w.y = cvt_pk_bf16(v0[2], v0[3]); w.z = cvt_pk_bf16(v1[0], v1[1]); w.w = cvt_pk_bf16(v1[2], v1[3]); \
                    *(u32x4*)(XB + xb_off(r, col0 + bj * 128)) = w; } \
                sA += __shfl_xor(sA, 16); sA += __shfl_xor(sA, 32); \
                if (gout) { sB += __shfl_xor(sB, 16); sB += __shfl_xor(sB, 32); } \
                if (fq == 0) { stat_add(ss_out, r, sA); if (gout) stat_add(s1_out, r, sB); } } while (0)
        u32x4 x0[4][2], x1[4][2];
#pragma unroll
        for (int m = 0; m < 4; ++m)
#pragma unroll
            for (int bj = 0; bj < 2; ++bj) x0[m][bj] = *(const u32x4*)(XB + xb_off(row0 + m * 16, col0 + bj * 128));
#pragma unroll
        for (int m = 0; m < 4; ++m) { RESID_ROW(0, m, x0[m]);
            if (m & 1) {
#pragma unroll
                for (int mm = m - 1; mm <= m; ++mm)
#pragma unroll
                    for (int bj = 0; bj < 2; ++bj) x1[mm][bj] = *(const u32x4*)(XB + xb_off(row0 + 128 + mm * 16, col0 + bj * 128)); } }
        asm volatile("" ::: "memory");
#pragma unroll
        for (int m = 0; m < 4; ++m) RESID_ROW(1, m, x1[m]);
#undef RESID_ROW
        { asm volatile("" ::: "memory"); }
    }
};
struct EpiQKV {
    static constexpr bool PERM = true, ZEROES = false;
    bf16_t* QKVb; const u64* ss; const float* qkg;
    __device__ __forceinline__ void operator()(const f32x4 (&acc)[2][2][4][2], const pg8::Unit& u, int wr, int wc, int fr, int fq) {
        float cfv[2][4];
        const int t = u.pn >> 3, row0 = u.pm * 256 + wr * 64 + fr, col0 = (u.pn & 7) * 256 + wc * 32 + 8 * fq;
        bf16_t* O = QKVb + (size_t)t * M * D;
        f32x4 ga = {1.f, 1.f, 1.f, 1.f}, gb = {1.f, 1.f, 1.f, 1.f};
#pragma unroll
        for (int ai = 0; ai < 2; ++ai)
#pragma unroll
            for (int m = 0; m < 4; ++m) cfv[ai][m] = row_cf(ss, ss, false, row0 + ai * 128 + m * 16);
        if (t < 2) { const float* gp = qkg + t * 64 + 8 * fq; ga = *(const f32x4*)gp; gb = *(const f32x4*)(gp + 4); if (t == 0) { ga = ga * QSCALE; gb = gb * QSCALE; } }
#pragma unroll
        for (int ai = 0; ai < 2; ++ai)
#pragma unroll
            for (int m = 0; m < 4; ++m) { const int r = row0 + ai * 128 + m * 16; const float cf = cfv[ai][m];
#pragma unroll
                for (int bj = 0; bj < 2; ++bj) { f32x4 v0 = acc[ai][bj][m][0] * cf, v1 = acc[ai][bj][m][1] * cf;
                    if (t < 2) { float q = (v0[0] * v0[0] + v0[1] * v0[1]) + (v0[2] * v0[2] + v0[3] * v0[3]) + (v1[0] * v1[0] + v1[1] * v1[1]) + (v1[2] * v1[2] + v1[3] * v1[3]);
                        q += __shfl_xor(q, 16); q += __shfl_xor(q, 32); const float hr = rsq(q * (1.0f / HD) + EPS); v0 = v0 * hr * ga; v1 = v1 * hr * gb; }
                    u32x4 w; w.x = cvt_pk_bf16(v0[0], v0[1]); w.y = cvt_pk_bf16(v0[2], v0[3]); w.z = cvt_pk_bf16(v1[0], v1[1]); w.w = cvt_pk_bf16(v1[2], v1[3]);
                    *(u32x4*)(O + (size_t)r * D + col0 + bj * 128) = w; } }
    }
};
struct EpiSguIn {
    static constexpr bool PERM = true, ZEROES = false;
    bf16_t* U; bf16_t* V; const u64* ss; u64* ssv;
    __device__ __forceinline__ void operator()(const f32x4 (&acc)[2][2][4][2], const pg8::Unit& u, int wr, int wc, int fr, int fq) {
        const int t = u.pn >> 4, row0 = u.pm * 256 + wr * 64 + fr, col0 = (u.pn & 15) * 256 + wc * 32 + 8 * fq;
        bf16_t* O = t ? V : U;
        float cfv[2][4];
#pragma unroll
        for (int ai = 0; ai < 2; ++ai)
#pragma unroll
            for (int m = 0; m < 4; ++m) cfv[ai][m] = row_cf(ss, ss, false, row0 + ai * 128 + m * 16);
#pragma unroll
        for (int ai = 0; ai < 2; ++ai)
#pragma unroll
            for (int m = 0; m < 4; ++m) { const int r = row0 + ai * 128 + m * 16; const float cf = cfv[ai][m]; float sv = 0.f;
#pragma unroll
                for (int bj = 0; bj < 2; ++bj) { const f32x4 v0 = acc[ai][bj][m][0] * cf, v1 = acc[ai][bj][m][1] * cf;
                    const f32x2 a = gelu_pk((f32x2){v0[0], v0[1]}), b = gelu_pk((f32x2){v0[2], v0[3]}), c = gelu_pk((f32x2){v1[0], v1[1]}), d = gelu_pk((f32x2){v1[2], v1[3]});
                    sv += (a.x * a.x + a.y * a.y) + (b.x * b.x + b.y * b.y) + (c.x * c.x + c.y * c.y) + (d.x * d.x + d.y * d.y);
                    u32x4 w; w.x = cvt_pk_bf16(a.x, a.y); w.y = cvt_pk_bf16(b.x, b.y); w.z = cvt_pk_bf16(c.x, c.y); w.w = cvt_pk_bf16(d.x, d.y);
                    *(u32x4*)(O + (size_t)r * DSGU + col0 + bj * 128) = w; }
                if (t) { sv += __shfl_xor(sv, 16); sv += __shfl_xor(sv, 32); if (fq == 0) stat_add(ssv, r, sv); } }
    }
};

constexpr size_t MiB = 1u << 20;
constexpr size_t WS_CTL = 0, CTL_ZERO_BYTES = 5 * MiB;
constexpr int CW_BAR = 1024;
constexpr size_t STAT_OFF = 65536;
constexpr int ST_F1 = 0, ST_S1 = 5, ST_MIX = 10, ST_F2 = 14, ST_V = 18, NSTAT = 19;
static_assert(STAT_OFF + (size_t)NSTAT * M * 8 <= CTL_ZERO_BYTES, "stats inside the memset region");
constexpr size_t WS_PAR = CTL_ZERO_BYTES;
constexpr int PAR_GOUT = 0, PAR_QG = 8192, PAR_KG = 8256  , PAR_RPB = 8320, PAR_VG = 67840, PAR_BS = 71936, PAR_WS = 73984, PAR_END = 336128;
static_assert(WS_PAR + (size_t)PAR_END * 4 <= 8 * MiB, "params region");
constexpr size_t WS_W = 8 * MiB;
constexpr size_t EL_FFN = (size_t)3 * D * DFF, EL_GU = (size_t)2 * D * DFF;
constexpr size_t EL_NA0 = 8 * EL_FFN, EL_NA = (size_t)4 * D * D, EL_QKV = (size_t)3 * D * D;
constexpr size_t EL_SGU = EL_NA0 + 2 * EL_NA, EL_SIN = (size_t)D * SGU_IN, EL_SOUT = (size_t)DSGU * D, EL_WS = (size_t)SGG * CHUNK * CHUNK;
constexpr size_t EL_POOL = EL_SGU + EL_SIN + EL_SOUT + EL_WS, EL_END = EL_POOL + (size_t)4 * PGD * PGD;
constexpr size_t WS_XB = WS_W + ((EL_END * 2 + MiB - 1) / MiB) * MiB;
constexpr size_t WS_BIG = WS_XB + (size_t)M * D * 2;
constexpr size_t WS_END = WS_BIG + 512 * MiB;

constexpr int RING_BYTES = 131072, MISC_OFF = RING_BYTES + 320, LDS_BYTES = 147456;

#define XB_TMO      128
#define XB_XCNT(j)  (256  + 64 * (j))
#define XB_XSUB(j)  (1280 + 64 * (j))
#define XB_XGEN(j)  (2304 + 64 * (j))
#define XB_TOP      3328
#define XB_TOPGEN   3392
#define XCD_BAR_WORDS 3456
#define XB_SPIN_CAP (1u << 18)
__device__ __forceinline__ unsigned xb_ld(unsigned* p)              { return __hip_atomic_load(p, __ATOMIC_RELAXED, __HIP_MEMORY_SCOPE_AGENT); }
__device__ __forceinline__ unsigned xb_add(unsigned* p, unsigned v) { return __hip_atomic_fetch_add(p, v, __ATOMIC_RELAXED, __HIP_MEMORY_SCOPE_AGENT); }
__device__ __forceinline__ unsigned xb_xcc_id() { return (unsigned)__builtin_amdgcn_s_getreg((3 << 11) | 20) & 0xFu; }
#define XB_SPIN(cond, bar) do { unsigned _sp = 0; while (cond) { __builtin_amdgcn_s_sleep(1); \
    if ((++_sp & 255u) == 0u) { if (xb_ld(&(bar)[XB_TMO])) break; if (_sp > XB_SPIN_CAP) { atomicAdd(&(bar)[XB_TMO], 1u); break; } } } } while (0)
struct XcdBarrier { unsigned* bar; unsigned x; volatile LAS unsigned* st; };
__device__ __forceinline__ XcdBarrier xcd_barrier_post(unsigned* bar, volatile LAS unsigned* st) {
    XcdBarrier b; b.bar = bar; b.x = xb_xcc_id(); b.st = st;
    if (threadIdx.x == 0) (void)xb_add(&bar[XB_XCNT(b.x)], 1u);
    return b;
}
__device__ __forceinline__ void xcd_barrier_complete(unsigned* bar, unsigned x, unsigned& nloc, unsigned& nx) {
    const unsigned G = gridDim.x * gridDim.y * gridDim.z;
    unsigned sum, cnt, mine, sp = 0u;
    for (;;) {
        sum = 0u; cnt = 0u; mine = 0u;
#pragma unroll
        for (unsigned j = 0; j < 16; ++j) { const unsigned c = xb_ld(&bar[XB_XCNT(j)]); sum += c; cnt += (c > 0u) ? 1u : 0u; mine = (j == x) ? c : mine; }
        if (sum == G) break;
        __builtin_amdgcn_s_sleep(1);
        if ((++sp & 255u) == 0u) { if (xb_ld(&bar[XB_TMO])) break; if (sp > XB_SPIN_CAP) { atomicAdd(&bar[XB_TMO], 1u); break; } }
    }
    nloc = mine > 0u ? mine : 1u; nx = cnt > 0u ? cnt : 1u;
}
__device__ __forceinline__ void xcd_barrier(const XcdBarrier& b) {
    asm volatile("s_waitcnt vmcnt(0)" ::: "memory");
    __syncthreads();
    if (threadIdx.x == 0) {
        unsigned* bar = b.bar;
        __builtin_amdgcn_s_waitcnt(0);
        unsigned nloc = b.st[0], nx = b.st[1];
        if (nloc == 0u) { xcd_barrier_complete(bar, b.x, nloc, nx); b.st[0] = nloc; b.st[1] = nx; }
        const unsigned old = xb_add(&bar[XB_XSUB(b.x)], 1u);
        const unsigned gen = old / nloc;
        if (old + 1u == (gen + 1u) * nloc) {
            __builtin_amdgcn_fence(__ATOMIC_RELEASE, "agent");
            asm volatile("s_waitcnt vmcnt(0)" ::: "memory");
            const unsigned og = xb_add(&bar[XB_TOP], 1u);
            const unsigned tg = og / nx;
            if (og + 1u == (tg + 1u) * nx) xb_add(&bar[XB_TOPGEN], 1u);
            else XB_SPIN(xb_ld(&bar[XB_TOPGEN]) == tg, bar);
            __builtin_amdgcn_fence(__ATOMIC_ACQUIRE, "agent");
            xb_add(&bar[XB_XGEN(b.x)], 1u);
            asm volatile("s_waitcnt vmcnt(0)" ::: "memory");
        } else {
            XB_SPIN(xb_ld(&bar[XB_XGEN(b.x)]) == gen, bar);
            __builtin_amdgcn_fence(__ATOMIC_ACQUIRE, "agent");
            asm volatile("s_waitcnt vmcnt(0)" ::: "memory");
        }
    }
    __syncthreads();
}

struct TrDesc { const float* W; bf16_t* WT; const float* gain; const float* nscale; float scale; int N, ldt, row_off, ilv, k0, n0; };
__device__ __forceinline__ void tr_set(TrDesc& d, const float* W, int K, int N, bf16_t* WT, int ldt, int row_off, int ilv, const float* gain, const float* nscale, float scale, int item) {
    const int nblk = N / 32, kb = item / nblk, nb = item % nblk; (void)K;
    d.W = W; d.WT = WT; d.gain = gain; d.nscale = nscale; d.scale = scale; d.N = N; d.ldt = ldt; d.row_off = row_off; d.ilv = ilv; d.k0 = 64 * kb; d.n0 = 32 * nb;
}
__device__ __forceinline__ void tr_load(const TrDesc& d, float (&v)[32], int lane) {
#pragma unroll
    for (int i = 0; i < 8; ++i) { const f32x4 q = *(const f32x4*)(d.W + (size_t)(d.k0 + 8 * i + (lane >> 3)) * d.N + d.n0 + 4 * (lane & 7));
        v[4 * i] = q[0]; v[4 * i + 1] = q[1]; v[4 * i + 2] = q[2]; v[4 * i + 3] = q[3]; }
}
__device__ __forceinline__ void tr_store(const TrDesc& d, const float (&v)[32], LAS float* scr, int lane) {
    f32x4 ns = {1.f, 1.f, 1.f, 1.f}; if (d.nscale) ns = *(const f32x4*)(d.nscale + d.n0 + 4 * (lane & 7)); ns = ns * d.scale;
#pragma unroll
    for (int i = 0; i < 8; ++i) { const int kk = 8 * i + (lane >> 3); const float gk = d.gain ? d.gain[d.k0 + kk] : 1.0f; LAS float* sp = scr + kk * 33 + 4 * (lane & 7);
#pragma unroll
        for (int j = 0; j < 4; ++j) sp[j] = v[4 * i + j] * (gk * ns[j]); }
    asm volatile("s_waitcnt lgkmcnt(0)" ::: "memory");
    const int c = lane & 7;
    const int rbase = d.ilv < 0 ? d.row_off + d.n0 : (d.n0 >> 7) * 256 + d.ilv * 128 + (d.n0 & 127);
#pragma unroll
    for (int j = 0; j < 4; ++j) { const int n = (lane >> 3) + 8 * j; const LAS float* sp = scr + (8 * c) * 33 + n;
        u32x4 o; o.x = cvt_pk_bf16(sp[0 * 33], sp[1 * 33]); o.y = cvt_pk_bf16(sp[2 * 33], sp[3 * 33]); o.z = cvt_pk_bf16(sp[4 * 33], sp[5 * 33]); o.w = cvt_pk_bf16(sp[6 * 33], sp[7 * 33]);
        const int R = rbase + 16 * ((n >> 2) & 1) + 4 * (n >> 3) + (n & 3);
        __builtin_nontemporal_store(o, (u32x4*)(d.WT + ((size_t)(R >> 4) * (d.ldt >> 5) + (d.k0 >> 5) + (c >> 2)) * 512 + (R & 15) * 32 + 8 * (c & 3))); }
    asm volatile("s_waitcnt lgkmcnt(0)" ::: "memory");
}

struct Args { const float* in[23]; float* out; unsigned char* ws; int ph_lo, ph_hi; };

__device__ __forceinline__ float wave_sum(float v) {
#pragma unroll
    for (int o = 1; o < 64; o <<= 1) v += __shfl_xor(v, o);
    return v;
}

__global__ void __launch_bounds__(512, 2) mega_fwd(Args a) {
    extern __shared__ __attribute__((aligned(16))) unsigned char lds_raw[];
    LAS unsigned char* lds = (LAS unsigned char*)lds_raw;
    volatile LAS unsigned* MISC = (volatile LAS unsigned*)(lds + MISC_OFF);
    const int tid = threadIdx.x, lane = tid & 63, wave = __builtin_amdgcn_readfirstlane(tid >> 6);
    const int G = gridDim.x, bx = blockIdx.x;
    const int vcu = (G % 8 == 0) ? (bx % 8) * (G / 8) + bx / 8 : bx;
    const int gw = vcu * 8 + wave, NGW = G * 8;
    unsigned char* ws = a.ws;
    unsigned* ctl = (unsigned*)(ws + WS_CTL);
    u64* stat = (u64*)(ws + STAT_OFF);
    float* par = (float*)(ws + WS_PAR);
    bf16_t* Wb = (bf16_t*)(ws + WS_W);
    bf16_t* XB = (bf16_t*)(ws + WS_XB);
    bf16_t* BIG = (bf16_t*)(ws + WS_BIG);
    float* X = a.out;
    for (int u = tid; u < (LDS_BYTES - RING_BYTES) / 4; u += 512) ((LAS unsigned*)(lds + RING_BYTES))[u] = 0u;
    __syncthreads();
    XcdBarrier bar = xcd_barrier_post(ctl + CW_BAR, MISC + 8);
    const int lo = a.ph_lo, hi = a.ph_hi;
    int pc = 0;
#ifndef PHMASK
#define PHMASK 0xffff
#endif
#define EN(k) (((PHMASK) >> (k)) & 1)
#define PH_ON (pc >= lo && pc < hi)
#define PH_END do { if (pc + 1 < hi) xcd_barrier(bar); } while (0)
#define STAT(i) (stat + (size_t)(i) * M)

    if (PH_ON && EN(0)) {
        LAS float* scr = (LAS float*)(lds + wave * 16384);
        constexpr int IT_FFN = 5632, N_FFN = 24 * IT_FFN, IT_QKV = 32 * 192, IT_WO = 32 * 64, IT_SIN = 32 * 256, IT_SOUT = 64 * 64, IT_POOL = 8 * 16;
        constexpr int N_ITEMS = N_FFN + 2 * (IT_QKV + IT_WO) + IT_SIN + IT_SOUT + 4 * IT_POOL;
#define TR_DECODE(IT, DD) do { int r = (IT); \
            if (r < N_FFN) { const int mat = r / IT_FFN, f = mat / 3, k = mat % 3, layer_ = f >> 1, which_ = f & 1; r -= mat * IT_FFN; bf16_t* base = Wb + (size_t)f * EL_FFN; \
                if (k < 2) tr_set(DD, a.in[(which_ ? 7 : 2) + k] + (size_t)layer_ * D * DFF, D, DFF, base, D, 0, k, a.in[which_ ? 6 : 1] + (size_t)layer_ * D, nullptr, 1.0f, r); \
                else tr_set(DD, a.in[which_ ? 9 : 4] + (size_t)layer_ * DFF * D, DFF, D, base + EL_GU, DFF, 0, -1, nullptr, nullptr, 0.5f, r); break; } \
            r -= N_FFN; \
            if (r < 2 * (IT_QKV + IT_WO)) { const int j = r / (IT_QKV + IT_WO); r -= j * (IT_QKV + IT_WO); \
                if (r < IT_QKV) tr_set(DD, a.in[11] + (size_t)j * D * NQKV, D, NQKV, Wb + EL_NA0 + j * EL_NA, D, 0, -1, a.in[5] + (size_t)(3 * j) * D, nullptr, 1.0f, r); \
                else tr_set(DD, a.in[15] + (size_t)j * D * D, D, D, Wb + EL_NA0 + j * EL_NA + EL_QKV, D, 0, -1, nullptr, nullptr, 1.0f, r - IT_QKV); break; } \
            r -= 2 * (IT_QKV + IT_WO); \
            if (r < IT_SIN) { tr_set(DD, a.in[16], D, SGU_IN, Wb + EL_SGU, D, 0, -1, a.in[5] + (size_t)1 * D, nullptr, 1.0f, r); break; } r -= IT_SIN; \
            if (r < IT_SOUT) { tr_set(DD, a.in[20], DSGU, D, Wb + EL_SGU + EL_SIN, DSGU, 0, -1, nullptr, nullptr, 1.0f, r); break; } r -= IT_SOUT; \
            { const int gp = r / IT_POOL; r -= gp * IT_POOL; \
              tr_set(DD, a.in[21] + (size_t)gp * PGD * PGD, PGD, PGD, Wb + EL_POOL, PGD, gp * PGD, -1, a.in[5] + (size_t)2 * D + gp * PGD, a.in[22] + gp * PGD, 1.0f, r); } } while (0)
        { TrDesc d0, d1; float v0[32], v1[32]; int it = gw; bool h0 = it < N_ITEMS;
          if (h0) { TR_DECODE(it, d0); tr_load(d0, v0, lane); }
          while (h0) {
              const int it1 = it + NGW; const bool h1 = it1 < N_ITEMS;
              if (h1) { TR_DECODE(it1, d1); tr_load(d1, v1, lane); }
              tr_store(d0, v0, scr, lane);
              if (!h1) break;
              it = it1 + NGW; h0 = it < N_ITEMS;
              if (h0) { TR_DECODE(it, d0); tr_load(d0, v0, lane); }
              tr_store(d1, v1, scr, lane);
          } }
#undef TR_DECODE
        { const float* wsrc = a.in[18]; bf16_t* wdst = Wb + EL_SGU + EL_SIN + EL_SOUT;
          for (int i = (gw * 64 + lane) * 2; i < (int)EL_WS; i += NGW * 128) *(unsigned*)(wdst + i) = cvt_pk_bf16(wsrc[i], wsrc[i + 1]); }
        { const int gt = gw * 64 + lane, NT = NGW * 64;
          for (int i = gt; i < 8192; i += NT) par[PAR_GOUT + i] = a.in[10][i];
          for (int i = gt; i < 64; i += NT) { par[PAR_QG + i] = a.in[12][i]; par[PAR_KG + i] = a.in[13][i]; }
          for (int i = gt; i < 59520; i += NT) par[PAR_RPB + i] = a.in[14][i] * LOG2E;
          for (int i = gt; i < 4096; i += NT) par[PAR_VG + i] = a.in[17][i];
          for (int i = gt; i < 2048; i += NT) par[PAR_BS + i] = a.in[19][i];
          for (int i = gt; i < 262144; i += NT) par[PAR_WS + i] = a.in[18][i]; }
        for (int m2 = gw; m2 < M / 2; m2 += NGW) {
            const int m = 2 * m2 + (lane >> 5), hl = lane & 31;
            const f32x4* xr = (const f32x4*)(a.in[0] + (size_t)m * D) + 2 * hl; bf16_t* bo = XB + xb_off(m, 8 * hl);
            float s = 0.f;
#pragma unroll
            for (int j = 0; j < 8; ++j) { const f32x4 v0 = xr[64 * j], v1 = xr[64 * j + 1];
                s += (v0[0] * v0[0] + v0[1] * v0[1]) + (v0[2] * v0[2] + v0[3] * v0[3]) + (v1[0] * v1[0] + v1[1] * v1[1]) + (v1[2] * v1[2] + v1[3] * v1[3]);
                u32x4 w; w.x = cvt_pk_bf16(v0[0], v0[1]); w.y = cvt_pk_bf16(v0[2], v0[3]); w.z = cvt_pk_bf16(v1[0], v1[1]); w.w = cvt_pk_bf16(v1[2], v1[3]); *(u32x4*)(bo + (size_t)j * 8 * 512) = w; }
#pragma unroll
            for (int o = 1; o < 32; o <<= 1) s += __shfl_xor(s, o);
            if (hl == 0) STAT(ST_F1 + 0)[m] = stat_fix(s);
        }
        PH_END;
    }
    ++pc;

    for (int step = 0; step < 2 * DEPTH; ++step) {
        const int layer = step >> 1, which = step & 1, kind = layer % 3, jm = layer / 3;
        if (which == 1) {
            if (kind == 0) {
                bf16_t* Q = BIG; bf16_t* Kb = BIG + (size_t)M * D; bf16_t* Vb = BIG + (size_t)2 * M * D; bf16_t* Ob = BIG + (size_t)3 * M * D;
                if (PH_ON && EN(6)) {

                    EpiQKV E{Q, STAT(ST_MIX + layer), par + PAR_QG + jm * HD};
                    pg8::gemm_phase<EpiQKV, pg8::Shape<NQKV, D, D, D, 0, 0, 8, 1>>(lds, XB, Wb + EL_NA0 + jm * EL_NA, G, bx, E);
                    PH_END;
                }
                ++pc;
                if (PH_ON && EN(2)) {
                    constexpr int VT_STRIDE = 1928, VT_OFF = 15 * 64 * 64, BI_OFF = VT_OFF + 32 * VT_STRIDE;
                    static_assert(BI_OFF + 529 * 4 <= RING_BYTES, "attention LDS");
                    int tq_ = threadIdx.x; asm volatile("" : "+v"(tq_));
                    const int tq = tq_, l = tq & 63, q = l & 15, g = l >> 4;
                    const float* rpbj = par + PAR_RPB + jm * NHEAD * 465;
                    for (int un = vcu; un < 2 * NHEAD * 32; un += G) {
                        const int h = un & 63, rb = (un >> 6) & 31, b = un >> 11;
                        const int R0 = rb * 8, KR0 = min(max(R0 - 4, 0), GROWS - 15);
                        const int r = R0 + wave, rs = min(max(r - 4, 0), GROWS - 8), krb = rs - KR0, drb = rs - r + 7;
                        bf16x8 qf[4];
#pragma unroll
                        for (int jb = 0; jb < 4; ++jb) qf[jb] = *(const bf16x8*)(Q + ((size_t)(b << 14) + r * 64 + 16 * jb + q) * D + h * 32 + 8 * g);
                        __syncthreads();
#pragma unroll
                        for (int e = 0; e < 4; ++e) { const int idx = tq + 512 * e;
                            if (idx < 15 * 32 * 4) { const int tok = (idx >> 2) * 2, ch = idx & 3; const size_t go = ((size_t)(b << 14) + KR0 * 64 + tok) * D + h * 32 + ch * 8;
                                const u32x4 ka = *(const u32x4*)(Kb + go), kb2 = *(const u32x4*)(Kb + go + D), va = *(const u32x4*)(Vb + go), vb = *(const u32x4*)(Vb + go + D);
                                *(LAS u32x4*)(lds + tok * 64 + ((ch ^ ((tok >> 2) & 3)) * 16)) = ka;
                                *(LAS u32x4*)(lds + (tok + 1) * 64 + ((ch ^ (((tok + 1) >> 2) & 3)) * 16)) = kb2;
                                LAS unsigned* vt = (LAS unsigned*)(lds + VT_OFF + (ch * 8) * VT_STRIDE + tok * 2); constexpr int VS = VT_STRIDE / 4;
                                vt[0 * VS] = (va.x & 0xffffu) | (vb.x << 16); vt[1 * VS] = (va.x >> 16) | (vb.x & 0xffff0000u); vt[2 * VS] = (va.y & 0xffffu) | (vb.y << 16); vt[3 * VS] = (va.y >> 16) | (vb.y & 0xffff0000u);
                                vt[4 * VS] = (va.z & 0xffffu) | (vb.z << 16); vt[5 * VS] = (va.z >> 16) | (vb.z & 0xffff0000u); vt[6 * VS] = (va.w & 0xffffu) | (vb.w << 16); vt[7 * VS] = (va.w >> 16) | (vb.w & 0xffff0000u); } }
                        if (tq < 529) ((LAS float*)(lds + BI_OFF))[tq] = (tq >= 32 && tq < 497) ? rpbj[h * 465 + tq - 32] : 0.f;
                        asm volatile("s_waitcnt vmcnt(0) lgkmcnt(0)" ::: "memory");
                        __syncthreads();
#pragma unroll 1
                        for (int jb = 0; jb < 4; ++jb) {
                            const int c = 16 * jb + q, cs = min(max(c - 8, 0), GRID_W - 16), kc0 = min(max(16 * jb - 8, 0), 32);
                            const int swz = (((kc0 >> 2) + (q >> 2)) & 3);
                            const bf16x8 qv = jb == 0 ? qf[0] : (jb == 1 ? qf[1] : (jb == 2 ? qf[2] : qf[3]));
                            f32x4 s[8][2];
#pragma unroll
                            for (int i = 0; i < 8; ++i)
#pragma unroll
                                for (int cb = 0; cb < 2; ++cb) { const int tokk = (krb + i) * 64 + kc0 + 16 * cb + q;
                                    const bf16x8 kf = *(const LAS bf16x8*)(lds + tokk * 64 + ((g ^ swz) * 16));
                                    s[i][cb] = __builtin_amdgcn_mfma_f32_16x16x32_bf16(kf, qv, (f32x4){0.f, 0.f, 0.f, 0.f}, 0, 0, 0); }
                            const int t = cs - kc0; bool sl[4]; const LAS float* blr[4];
                            const LAS float* bl = (const LAS float*)(lds + BI_OFF) + (32 + drb * 31 + kc0 + 4 * g - c + 15);
#pragma unroll
                            for (int rg = 0; rg < 4; ++rg) { sl[rg] = (4 * g + rg) >= t; blr[rg] = bl + (sl[rg] ? rg : 16 + rg); }
                            const unsigned m01 = (sl[0] ? 0xffffu : 0u) | (sl[1] ? 0xffff0000u : 0u), m23 = (sl[2] ? 0xffffu : 0u) | (sl[3] ? 0xffff0000u : 0u);
                            float mx = -1e30f;
#pragma unroll
                            for (int i = 0; i < 8; ++i)
#pragma unroll
                                for (int rg = 0; rg < 4; ++rg) { const float v = (sl[rg] ? s[i][0][rg] : s[i][1][rg]) + blr[rg][31 * i]; s[i][0][rg] = v; mx = fmaxf(mx, v); }
                            mx = fmaxf(mx, __shfl_xor(mx, 16)); mx = fmaxf(mx, __shfl_xor(mx, 32));
                            float sum = 0.f; bf16x8 pb[8];
#pragma unroll
                            for (int i = 0; i < 8; ++i) { float p[4];
#pragma unroll
                                for (int rg = 0; rg < 4; ++rg) { p[rg] = __builtin_amdgcn_exp2f(s[i][0][rg] - mx); sum += p[rg]; }
                                const unsigned p01 = cvt_pk_bf16(p[0], p[1]), p23 = cvt_pk_bf16(p[2], p[3]);
                                u32x4 w; w.x = p01 & m01; w.y = p23 & m23; w.z = p01 & ~m01; w.w = p23 & ~m23;
                                pb[i] = __builtin_bit_cast(bf16x8, w); }
                            sum += __shfl_xor(sum, 16); sum += __shfl_xor(sum, 32);
                            f32x4 o0 = {0.f, 0.f, 0.f, 0.f}, o1 = {0.f, 0.f, 0.f, 0.f};
#pragma unroll
                            for (int i = 0; i < 8; ++i) { const LAS unsigned char* vb = lds + VT_OFF + q * VT_STRIDE + ((krb + i) * 64 + kc0 + 4 * g) * 2;
                                const u32x2 a0 = *(const LAS u32x2*)(vb), a1 = *(const LAS u32x2*)(vb + 32), c0 = *(const LAS u32x2*)(vb + 16 * VT_STRIDE), c1 = *(const LAS u32x2*)(vb + 16 * VT_STRIDE + 32);
                                const bf16x8 va = __builtin_bit_cast(bf16x8, (u32x4){a0.x, a0.y, a1.x, a1.y}), vc = __builtin_bit_cast(bf16x8, (u32x4){c0.x, c0.y, c1.x, c1.y});
                                o0 = __builtin_amdgcn_mfma_f32_16x16x32_bf16(va, pb[i], o0, 0, 0, 0); o1 = __builtin_amdgcn_mfma_f32_16x16x32_bf16(vc, pb[i], o1, 0, 0, 0); }
                            const float inv = 1.0f / sum; bf16_t* op = Ob + ((size_t)(b << 14) + r * 64 + c) * D + h * 32 + 4 * g;
                            u32x2 w0v, w1v; w0v.x = cvt_pk_bf16(o0[0] * inv, o0[1] * inv); w0v.y = cvt_pk_bf16(o0[2] * inv, o0[3] * inv); w1v.x = cvt_pk_bf16(o1[0] * inv, o1[1] * inv); w1v.y = cvt_pk_bf16(o1[2] * inv, o1[3] * inv);
                            *(u32x2*)op = w0v; *(u32x2*)(op + 16) = w1v;
                        }
                    }
                    PH_END;
                }
                ++pc;
                if (PH_ON && EN(7)) {

                    EpiResid E{XB, STAT(ST_F2 + layer), false, STAT(ST_F2 + layer), nullptr, nullptr};
                    pg8::gemm_phase<EpiResid, pg8::Shape<D, D, D, D, 0, 0, 4>>(lds, Ob, Wb + EL_NA0 + jm * EL_NA + EL_QKV, G, bx, E);
                    PH_END;
                }
                ++pc;
            } else if (kind == 1) {
                bf16_t* U = BIG; bf16_t* V = BIG + (size_t)M * DSGU;
                if (PH_ON && EN(8)) {

                    EpiSguIn E{U, V, STAT(ST_MIX + layer), STAT(ST_V)};
                    pg8::gemm_phase<EpiSguIn, pg8::Shape<SGU_IN, D, D, D, 0, 0, 8, 1>>(lds, XB, Wb + EL_SGU, G, bx, E);
                    PH_END;
                }
                ++pc;

                if (PH_ON && EN(3)) {
                    constexpr int LSTR = 272, VN_OFF = 128 * LSTR;
                    static_assert(VN_OFF + 256 * LSTR <= RING_BYTES, "SGU LDS");
                    int tq_ = threadIdx.x; asm volatile("" : "+v"(tq_));
                    const int tq = tq_, l = tq & 63, q = l & 15, g = l >> 4;
                    const u64* ssv = STAT(ST_V);
                    const int gq = bx & 15;
                    if ((G & 15) == 0) {
                        const bf16_t* wsrc = Wb + EL_SGU + EL_SIN + EL_SOUT + (size_t)gq * CHUNK * CHUNK;
#pragma unroll
                        for (int e = 0; e < 4; ++e) { const int id = tq + 512 * e, i = id >> 4, cj = id & 15; *(LAS u32x4*)(lds + i * LSTR + cj * 16) = *(const u32x4*)(wsrc + i * CHUNK + cj * 8); }
                    }
                    for (int un = bx; un < (M / CHUNK) * SGG; un += G) {
                        const int n = un >> 4;
                        __syncthreads();
                        if ((G & 15) != 0) {
                            const bf16_t* wsrc = Wb + EL_SGU + EL_SIN + EL_SOUT + (size_t)(un & 15) * CHUNK * CHUNK;
#pragma unroll
                            for (int e = 0; e < 4; ++e) { const int id = tq + 512 * e, i = id >> 4, cj = id & 15; *(LAS u32x4*)(lds + i * LSTR + cj * 16) = *(const u32x4*)(wsrc + i * CHUNK + cj * 8); }
                        }
                        const int gu = un & 15;
#pragma unroll
                        for (int e = 0; e < 4; ++e) { const int id = tq + 512 * e, j = (id & 63) * 2, cc = id >> 6; const int tok = n * CHUNK + j;
                            const u32x4 va = *(const u32x4*)(V + (size_t)tok * DSGU + gu * SGD + cc * 8), vb = *(const u32x4*)(V + (size_t)(tok + 1) * DSGU + gu * SGD + cc * 8);
                            const float ra = rsq(stat_get(ssv, tok) * (1.0f / DSGU) + EPS), rb = rsq(stat_get(ssv, tok + 1) * (1.0f / DSGU) + EPS);
                            LAS unsigned* vt = (LAS unsigned*)(lds + VN_OFF + (cc * 8) * LSTR + j * 2); constexpr int VS = LSTR / 4;
#define B2_PAIR(dd, W) do { vt[(2 * dd) * VS] = cvt_pk_bf16(bflo(va.W) * ra, bflo(vb.W) * rb); vt[(2 * dd + 1) * VS] = cvt_pk_bf16(bfhi(va.W) * ra, bfhi(vb.W) * rb); } while (0)
                            B2_PAIR(0, x); B2_PAIR(1, y); B2_PAIR(2, z); B2_PAIR(3, w);
#undef B2_PAIR
                        }
                        asm volatile("s_waitcnt vmcnt(0) lgkmcnt(0)" ::: "memory");
                        __syncthreads();
                        f32x4 acc[2][8];
#pragma unroll
                        for (int ct = 0; ct < 2; ++ct)
#pragma unroll
                            for (int it = 0; it < 8; ++it) acc[ct][it] = (f32x4){0.f, 0.f, 0.f, 0.f};
#pragma unroll
                        for (int ks = 0; ks < 4; ++ks) {
                            const bf16x8 a0 = *(const LAS bf16x8*)(lds + VN_OFF + (32 * wave + q) * LSTR + (ks * 32 + 8 * g) * 2), a1 = *(const LAS bf16x8*)(lds + VN_OFF + (32 * wave + 16 + q) * LSTR + (ks * 32 + 8 * g) * 2);
#pragma unroll
                            for (int it = 0; it < 8; ++it) { const bf16x8 wf = *(const LAS bf16x8*)(lds + (16 * it + q) * LSTR + (ks * 32 + 8 * g) * 2);
                                acc[0][it] = __builtin_amdgcn_mfma_f32_16x16x32_bf16(a0, wf, acc[0][it], 0, 0, 0); acc[1][it] = __builtin_amdgcn_mfma_f32_16x16x32_bf16(a1, wf, acc[1][it], 0, 0, 0); }
                        }
#pragma unroll
                        for (int ct = 0; ct < 2; ++ct) { const int chb = gu * SGD + 32 * wave + 16 * ct + 4 * g; const f32x4 gn = *(const f32x4*)(par + PAR_VG + chb);
#pragma unroll
                            for (int it = 0; it < 8; ++it) { const int i = 16 * it + q; const float bs = par[PAR_BS + gu * CHUNK + i];
                                bf16_t* up = U + (size_t)(n * CHUNK + i) * DSGU + chb; const u32x2 uw = *(const u32x2*)up; const f32x4 a = acc[ct][it];
                                u32x2 w; w.x = cvt_pk_bf16(bflo(uw.x) * (gn[0] * a[0] + bs), bfhi(uw.x) * (gn[1] * a[1] + bs)); w.y = cvt_pk_bf16(bflo(uw.y) * (gn[2] * a[2] + bs), bfhi(uw.y) * (gn[3] * a[3] + bs));
                                *(u32x2*)up = w; } }
                    }
                    PH_END;
                }
                ++pc;
                if (PH_ON && EN(9)) {

                    EpiResid E{XB, STAT(ST_F2 + layer), false, STAT(ST_F2 + layer), nullptr, nullptr};
                    pg8::gemm_phase<EpiResid, pg8::Shape<D, DSGU, DSGU, DSGU, 0, 0, 4>>(lds, U, Wb + EL_SGU + EL_SIN, G, bx, E);
                    PH_END;
                }
                ++pc;
            } else {
                bf16_t* P = BIG;
                if (PH_ON && EN(4)) {
                    const u64* ssm = STAT(ST_MIX + layer);
                    const int gi = lane >> 4, hw = 1 << gi;
#define POOL_ROW(ROWT, WGT, OP) do { const int sx_ = (ROWT); const bool in_ = (sx_ >= 0) && (sx_ < SEQ) && (WGT); const int row_ = (b << 14) + min(max(sx_, 0), SEQ - 1); \
        const float rs_ = in_ ? rsq(stat_get(ssm, row_) * (1.0f / D) + EPS) : 0.f; const u32x4* xp_ = (const u32x4*)(XB + xb_off(row_, lane * 32)); \
        _Pragma("unroll") for (int e = 0; e < 4; ++e) { const u32x4 w_ = xp_[e]; \
            sum[8 * e + 0] OP bflo(w_.x) * rs_; sum[8 * e + 1] OP bfhi(w_.x) * rs_; sum[8 * e + 2] OP bflo(w_.y) * rs_; sum[8 * e + 3] OP bfhi(w_.y) * rs_; \
            sum[8 * e + 4] OP bflo(w_.z) * rs_; sum[8 * e + 5] OP bfhi(w_.z) * rs_; sum[8 * e + 6] OP bflo(w_.w) * rs_; sum[8 * e + 7] OP bfhi(w_.w) * rs_; } } while (0)
                    for (int run = gw; run < M / 16; run += NGW) {
                        const int t0 = run * 16, b = t0 >> 14, tt0 = t0 & 16383;
                        float sum[32];
#pragma unroll
                        for (int e = 0; e < 32; ++e) sum[e] = 0.f;
#pragma unroll 4
                        for (int off = -8; off < 8; ++off) POOL_ROW(tt0 + off, (off >= -hw) && (off < hw), +=);
#pragma unroll 2
                        for (int k = 0; k < 16; ++k) {
                            const int tt = tt0 + k, t = t0 + k;
                            const float ic = 1.0f / (float)(min(tt + hw, SEQ) - max(tt - hw, 0)), rst = rsq(stat_get(ssm, t) * (1.0f / D) + EPS);
                            const u32x4* xs = (const u32x4*)(XB + xb_off(t, lane * 32)); u32x4* pp = (u32x4*)(P + (size_t)t * D + lane * 32);
#pragma unroll
                            for (int e = 0; e < 4; ++e) { const u32x4 x = xs[e]; u32x4 w;
                                w.x = cvt_pk_bf16(sum[8 * e + 0] * ic - bflo(x.x) * rst, sum[8 * e + 1] * ic - bfhi(x.x) * rst); w.y = cvt_pk_bf16(sum[8 * e + 2] * ic - bflo(x.y) * rst, sum[8 * e + 3] * ic - bfhi(x.y) * rst);
                                w.z = cvt_pk_bf16(sum[8 * e + 4] * ic - bflo(x.z) * rst, sum[8 * e + 5] * ic - bfhi(x.z) * rst); w.w = cvt_pk_bf16(sum[8 * e + 6] * ic - bflo(x.w) * rst, sum[8 * e + 7] * ic - bfhi(x.w) * rst); pp[e] = w; }
                            POOL_ROW(tt + hw, true, +=);
                            POOL_ROW(tt - hw, true, -=);
                        }
                    }
#undef POOL_ROW
                    PH_END;
                }
                ++pc;
                if (PH_ON && EN(10)) {

                    EpiResid E{XB, STAT(ST_F2 + layer), false, STAT(ST_F2 + layer), nullptr, nullptr};
                    pg8::gemm_phase<EpiResid, pg8::Shape<D, PGD, D, PGD, 2, PGD * 2>>(lds, P, Wb + EL_POOL, G, bx, E);
                    PH_END;
                }
                ++pc;
            }
        }
        bf16_t* H = BIG;
        const bf16_t* Wf = Wb + (size_t)step * EL_FFN;
        if (PH_ON && EN(11)) {

            EpiSwiGLU E{H, which ? STAT(ST_F2 + layer) : STAT(ST_F1 + layer), STAT(ST_S1 + layer), (which == 0 && layer > 0), -1, {}};
            pg8::gemm_phase<EpiSwiGLU, pg8::Shape<2 * DFF, D, D, D, 0, 0, 8, 1>>(lds, XB, Wf, G, bx, E);
            PH_END;
        }
        ++pc;

        if (PH_ON && EN(12)) {

            EpiResid E{XB, STAT(ST_S1 + layer), (which == 0 && layer > 0), which ? STAT(ST_F1 + layer + 1) : STAT(ST_MIX + layer),
                       which ? par + PAR_GOUT + layer * D : nullptr, which ? STAT(ST_S1 + layer + 1) : nullptr};
            pg8::gemm_phase<EpiResid, pg8::Shape<D, DFF, DFF, DFF, 0, 0, 4, 1>>(lds, H, Wf + EL_GU, G, bx, E);
            PH_END;
        }
        ++pc;
    }
    if (PH_ON && EN(5)) {
        const u64* s1 = STAT(ST_S1 + DEPTH);
        for (int m2 = gw; m2 < M / 2; m2 += NGW) { const int m = 2 * m2 + (lane >> 5), hl = lane & 31;
            const float ps = rsq(stat_get(s1, m) * (1.0f / D) + EPS); f32x4* xo = (f32x4*)(X + (size_t)m * D) + 2 * hl; const bf16_t* xb = XB + xb_off(m, 8 * hl);
#pragma unroll
            for (int j = 0; j < 8; ++j) { const u32x4 w = *(const u32x4*)(xb + (size_t)j * 8 * 512);
                xo[64 * j] = (f32x4){bflo(w.x), bfhi(w.x), bflo(w.y), bfhi(w.y)} * ps; xo[64 * j + 1] = (f32x4){bflo(w.z), bfhi(w.z), bflo(w.w), bfhi(w.w)} * ps; } }
    }
    ++pc;
}

constexpr int N_PHASES = 1 + DEPTH * 4 + 3 + 3 + 2 + 3 + 1;
#ifndef MK_PER_PHASE
#define MK_PER_PHASE 0
#endif

extern "C" void kernel_launch(void* const* d_in, const int* in_sizes, int n_in, void* d_out, int out_size, void* d_ws, size_t ws_size, hipStream_t stream) {
    static int grid = 0;
    if (grid == 0) {
        if (n_in != 23 || in_sizes[0] != M * D || out_size != M * D || ws_size < WS_END) { fprintf(stderr, "kernel_launch: unexpected problem (n_in %d, in0 %d, out %d, ws %zu < %zu)\n", n_in, n_in > 0 ? in_sizes[0] : -1, out_size, ws_size, (size_t)WS_END); grid = -1; return; }
        int dev = 0, cus = 0, per_cu = 0;
        if (hipGetDevice(&dev) != hipSuccess || hipDeviceGetAttribute(&cus, hipDeviceAttributeMultiprocessorCount, dev) != hipSuccess) { grid = -1; return; }
        if (hipFuncSetAttribute((const void*)mega_fwd, hipFuncAttributeMaxDynamicSharedMemorySize, LDS_BYTES) != hipSuccess) { fprintf(stderr, "kernel_launch: hipFuncSetAttribute failed\n"); grid = -1; return; }
        if (hipOccupancyMaxActiveBlocksPerMultiprocessor(&per_cu, (const void*)mega_fwd, 512, LDS_BYTES) != hipSuccess || per_cu < 1) fprintf(stderr, "kernel_launch: occupancy query says %d\n", per_cu);
        (void)hipGetLastError();
        grid = cus;
    }
    if (grid < 0) return;
    (void)hipMemsetAsync((char*)d_ws + WS_CTL, 0, CTL_ZERO_BYTES, stream);
    Args a{};
    for (int i = 0; i < 23; ++i) a.in[i] = (const float*)d_in[i];
    a.out = (float*)d_out; a.ws = (unsigned char*)d_ws;
#if MK_PER_PHASE
    for (int p = 0; p < N_PHASES; ++p) { a.ph_lo = p; a.ph_hi = p + 1; hipLaunchKernelGGL(mega_fwd, dim3(grid), dim3(512), LDS_BYTES, stream, a); }
#else
    a.ph_lo = 0; a.ph_hi = N_PHASES;
    hipLaunchKernelGGL(mega_fwd, dim3(grid), dim3(512), LDS_BYTES, stream, a);
#endif
}
```
